# Optimizing an MI355X kernel written in HIP

```python
import jax, jax.numpy as jnp
from jax import lax
import numpy as np

D_MODEL = 1024
BATCH = 2
SEQ = 16384
DEPTH = 2
DEC_BATCH = 8
DEC_SEQ = 64
PAST_LEN = 2048

CHUNK = 64
LEFT_CHUNKS = 8
LEFT_CTX = LEFT_CHUNKS * CHUNK
BAND = LEFT_CTX + CHUNK
N_HEADS = 16
HEAD_DIM = D_MODEL // N_HEADS
REL_CLIP = 128
N_REL = 2 * REL_CLIP + 1
CONV_WIDTH = 31
D_FF = ((8 * D_MODEL // 3 + 127) // 128) * 128
N_ATTN_LAYERS = (DEPTH + 1) // 2
N_CONV_LAYERS = DEPTH // 2
EPS = 1e-6
NEG_INF = -1e30

kernel_name = 'chunk_stream_conformer_hybrid'


def rms_norm(x, g):
    xf = x.astype(jnp.float32)
    y = xf * lax.rsqrt(jnp.mean(xf * xf, axis=-1, keepdims=True) + EPS)
    return (y * g.astype(jnp.float32)).astype(x.dtype)


def layer_norm(x, g, b):
    xf = x.astype(jnp.float32)
    mu = jnp.mean(xf, axis=-1, keepdims=True)
    xc = xf - mu
    y = xc * lax.rsqrt(jnp.mean(xc * xc, axis=-1, keepdims=True) + EPS)
    return (y * g.astype(jnp.float32) + b.astype(jnp.float32)).astype(x.dtype)


def swiglu_ffn(x, g, w_gate, w_up, w_down):
    h = rms_norm(x, g)
    return (jax.nn.silu(h @ w_gate) * (h @ w_up)) @ w_down


def rel_bias(table):
    i = jnp.arange(CHUNK)[:, None]
    j = jnp.arange(BAND)[None, :]
    dist = LEFT_CTX + i - j
    idx = jnp.clip(dist, -REL_CLIP, REL_CLIP) + REL_CLIP
    return jnp.transpose(table[idx], (2, 0, 1)).astype(jnp.float32)


def chunk_band_attention(x, cache_k, cache_v, norm_g, w_qkv, q_gain, k_gain, rel_table, w_o):
    bsz, t, _ = x.shape
    past = cache_k.shape[1]
    n_chunks = -(-t // CHUNK)
    t_pad = n_chunks * CHUNK
    h = rms_norm(x, norm_g)
    q, k, v = jnp.split(h @ w_qkv, 3, axis=-1)
    q = rms_norm(q.reshape(bsz, t, N_HEADS, HEAD_DIM), q_gain)
    k = rms_norm(k.reshape(bsz, t, N_HEADS, HEAD_DIM), k_gain)
    v = v.reshape(bsz, t, N_HEADS, HEAD_DIM)
    qp = jnp.pad(q, ((0, 0), (0, t_pad - t), (0, 0), (0, 0)))
    pad_kv = ((0, 0), (LEFT_CTX, t_pad - t), (0, 0), (0, 0))
    kp = jnp.pad(jnp.concatenate([cache_k.astype(k.dtype), k], axis=1), pad_kv)
    vp = jnp.pad(jnp.concatenate([cache_v.astype(v.dtype), v], axis=1), pad_kv)
    bias = rel_bias(rel_table)
    scale = HEAD_DIM ** -0.5
    n_keys = past + t

    def one_chunk(c):
        start = c * CHUNK
        q_c = lax.dynamic_slice_in_dim(qp, start, CHUNK, axis=1)
        k_b = lax.dynamic_slice_in_dim(kp, past + start, BAND, axis=1)
        v_b = lax.dynamic_slice_in_dim(vp, past + start, BAND, axis=1)
        kpos = past + start - LEFT_CTX + jnp.arange(BAND)
        valid = (kpos >= 0) & (kpos < n_keys)
        s = jnp.einsum('bqhd,bkhd->bhqk', q_c, k_b).astype(jnp.float32) * scale + bias
        s = jnp.where(valid, s, NEG_INF)
        p = jax.nn.softmax(s, axis=-1).astype(v_b.dtype)
        return jnp.einsum('bhqk,bkhd->bqhd', p, v_b)

    o = lax.map(one_chunk, jnp.arange(n_chunks))
    o = jnp.moveaxis(o, 0, 1).reshape(bsz, t_pad, D_MODEL)[:, :t]
    return o @ w_o, k, v


def conformer_conv(x, buf, norm_g, w_pw1, b_pw1, w_dw, b_dw, ln_g, ln_b, w_pw2, b_pw2):
    h = rms_norm(x, norm_g)
    a, gate = jnp.split(h @ w_pw1 + b_pw1, 2, axis=-1)
    u = a * jax.nn.sigmoid(gate)
    ext = jnp.concatenate([buf.astype(u.dtype), u], axis=1)
    y = lax.conv_general_dilated(ext, w_dw[:, None, :].astype(ext.dtype), (1,), 'VALID',
                                 dimension_numbers=('NWC', 'WIO', 'NWC'),
                                 feature_group_count=D_MODEL) + b_dw
    y = jax.nn.silu(layer_norm(y, ln_g, ln_b))
    return y @ w_pw2 + b_pw2, ext[:, -(CONV_WIDTH - 1):]


def trunk(x, k_caches, v_caches, conv_bufs, p):
    new_k, new_v, new_conv = [], [], []
    for i in range(DEPTH):
        x = x + 0.5 * swiglu_ffn(x, p['ffn1_norm'][i], p['ffn1_w_gate'][i], p['ffn1_w_up'][i], p['ffn1_w_down'][i])
        if i % 2 == 0:
            a = i // 2
            out, k, v = chunk_band_attention(x, k_caches[a], v_caches[a], p['attn_norm'][a], p['attn_w_qkv'][a],
                                             p['attn_q_gain'][a], p['attn_k_gain'][a], p['attn_rel_bias'][a],
                                             p['attn_w_o'][a])
            new_k.append(k)
            new_v.append(v)
        else:
            b = i // 2
            out, nb = conformer_conv(x, conv_bufs[b], p['conv_norm'][b], p['conv_w_pw1'][b], p['conv_b_pw1'][b],
                                     p['conv_w_dw'][b], p['conv_b_dw'][b], p['conv_ln_g'][b], p['conv_ln_b'][b],
                                     p['conv_w_pw2'][b], p['conv_b_pw2'][b])
            new_conv.append(nb)
        x = x + out
        x = x + 0.5 * swiglu_ffn(x, p['ffn2_norm'][i], p['ffn2_w_gate'][i], p['ffn2_w_up'][i], p['ffn2_w_down'][i])
    return x, jnp.stack(new_k), jnp.stack(new_v), jnp.stack(new_conv)


def setup_inputs(seed: int = 0) -> dict:
    key = jax.random.key(seed)
    ks = iter(jax.random.split(key, 40))
    f32 = jnp.float32

    def nrm(shape, scale):
        return jax.random.normal(next(ks), shape, f32) * scale

    def gain(shape):
        return 1.0 + nrm(shape, 0.05)

    cache_len = min(LEFT_CTX, PAST_LEN)
    A, C = N_ATTN_LAYERS, N_CONV_LAYERS
    return {
        'x_prompt': nrm((BATCH, SEQ, D_MODEL), 1.0),
        'x_sample': nrm((DEC_BATCH, DEC_SEQ, D_MODEL), 1.0),
        'cache_attn_k': nrm((A, DEC_BATCH, cache_len, N_HEADS, HEAD_DIM), 1.0),
        'cache_attn_v': nrm((A, DEC_BATCH, cache_len, N_HEADS, HEAD_DIM), 1.0),
        'state_conv': nrm((C, DEC_BATCH, CONV_WIDTH - 1, D_MODEL), 0.5),
        'ffn1_norm': gain((DEPTH, D_MODEL)),
        'ffn1_w_gate': nrm((DEPTH, D_MODEL, D_FF), D_MODEL ** -0.5),
        'ffn1_w_up': nrm((DEPTH, D_MODEL, D_FF), D_MODEL ** -0.5),
        'ffn1_w_down': nrm((DEPTH, D_FF, D_MODEL), D_FF ** -0.5),
        'ffn2_norm': gain((DEPTH, D_MODEL)),
        'ffn2_w_gate': nrm((DEPTH, D_MODEL, D_FF), D_MODEL ** -0.5),
        'ffn2_w_up': nrm((DEPTH, D_MODEL, D_FF), D_MODEL ** -0.5),
        'ffn2_w_down': nrm((DEPTH, D_FF, D_MODEL), D_FF ** -0.5),
        'attn_norm': gain((A, D_MODEL)),
        'attn_w_qkv': nrm((A, D_MODEL, 3 * D_MODEL), D_MODEL ** -0.5),
        'attn_q_gain': gain((A, HEAD_DIM)),
        'attn_k_gain': gain((A, HEAD_DIM)),
        'attn_rel_bias': nrm((A, N_REL, N_HEADS), 0.5),
        'attn_w_o': nrm((A, D_MODEL, D_MODEL), D_MODEL ** -0.5),
        'conv_norm': gain((C, D_MODEL)),
        'conv_w_pw1': nrm((C, D_MODEL, 2 * D_MODEL), D_MODEL ** -0.5),
        'conv_b_pw1': nrm((C, 2 * D_MODEL), 0.02),
        'conv_w_dw': nrm((C, CONV_WIDTH, D_MODEL), CONV_WIDTH ** -0.5),
        'conv_b_dw': nrm((C, D_MODEL), 0.02),
        'conv_ln_g': gain((C, D_MODEL)),
        'conv_ln_b': nrm((C, D_MODEL), 0.02),
        'conv_w_pw2': nrm((C, D_MODEL, D_MODEL), D_MODEL ** -0.5),
        'conv_b_pw2': nrm((C, D_MODEL), 0.02),
    }


def reference(x_prompt, x_sample, cache_attn_k, cache_attn_v, state_conv,
              ffn1_norm, ffn1_w_gate, ffn1_w_up, ffn1_w_down,
              ffn2_norm, ffn2_w_gate, ffn2_w_up, ffn2_w_down,
              attn_norm, attn_w_qkv, attn_q_gain, attn_k_gain, attn_rel_bias, attn_w_o,
              conv_norm, conv_w_pw1, conv_b_pw1, conv_w_dw, conv_b_dw, conv_ln_g, conv_ln_b,
              conv_w_pw2, conv_b_pw2):
    p = dict(ffn1_norm=ffn1_norm, ffn1_w_gate=ffn1_w_gate, ffn1_w_up=ffn1_w_up, ffn1_w_down=ffn1_w_down,
             ffn2_norm=ffn2_norm, ffn2_w_gate=ffn2_w_gate, ffn2_w_up=ffn2_w_up, ffn2_w_down=ffn2_w_down,
             attn_norm=attn_norm, attn_w_qkv=attn_w_qkv, attn_q_gain=attn_q_gain, attn_k_gain=attn_k_gain,
             attn_rel_bias=attn_rel_bias, attn_w_o=attn_w_o,
             conv_norm=conv_norm, conv_w_pw1=conv_w_pw1, conv_b_pw1=conv_b_pw1, conv_w_dw=conv_w_dw,
             conv_b_dw=conv_b_dw, conv_ln_g=conv_ln_g, conv_ln_b=conv_ln_b, conv_w_pw2=conv_w_pw2,
             conv_b_pw2=conv_b_pw2)
    bp, sp = x_prompt.shape[0], x_prompt.shape[1]
    empty_kv = jnp.zeros((N_ATTN_LAYERS, bp, 0, N_HEADS, HEAD_DIM), x_prompt.dtype)
    zero_conv = jnp.zeros((N_CONV_LAYERS, bp, CONV_WIDTH - 1, D_MODEL), x_prompt.dtype)
    y_prompt, k_p, v_p, new_conv_prompt = trunk(x_prompt, empty_kv, empty_kv, zero_conv, p)
    keep = min(LEFT_CTX, sp)
    new_attn_k_prompt = k_p[:, :, sp - keep:]
    new_attn_v_prompt = v_p[:, :, sp - keep:]
    y_sample, new_attn_k_sample, new_attn_v_sample, new_conv_sample = trunk(
        x_sample, cache_attn_k, cache_attn_v, state_conv, p)
    return (y_prompt, y_sample, new_attn_k_prompt, new_attn_v_prompt,
            new_attn_k_sample, new_attn_v_sample, new_conv_prompt, new_conv_sample)
```

```cpp
#include <hip/hip_runtime.h>
#include <hip/hip_cooperative_groups.h>
#include <cstdio>
#include <cstdint>
namespace cg = cooperative_groups;
namespace pg8 {
#define PG8_LAS __attribute__((address_space(3)))
typedef unsigned short bf16_t;
typedef short bf16x8 __attribute__((ext_vector_type(8)));
typedef float f32x4 __attribute__((ext_vector_type(4)));
typedef unsigned u32x4 __attribute__((ext_vector_type(4)));
constexpr int BM = 256, BK = 64, HALF = 128, HTB = HALF * BK * 2  , STAGE_BYTES = 8 * HTB, NXCD = 8, WGM = 8;

__host__ __device__ __forceinline__ int lds_byte(int r, int c) { const int st = (r >> 4) * 2 + (c >> 5), rr = r & 15, cc = c & 31, ob = rr * 64 + cc * 2; return st * 1024 + (ob ^ (((ob >> 9) & 1) << 5)); }
__host__ __device__ __forceinline__ void stage_rc(int b, int& R, int& C) { const int st = b / 1024, sb = b % 1024, swz = sb ^ (((sb >> 9) & 1) << 5); R = (st >> 1) * 16 + swz / 64; C = (st & 1) * 32 + (swz % 64) / 2; }
__host__ __device__ __forceinline__ int perm32(int rho) { const int n = rho >> 4, i = rho & 15; return 8 * (i >> 2) + 4 * n + (i & 3); }

struct Unit { int pm, pn; };
struct Gemm { const bf16_t* A; const bf16_t* Bt; int M, N, K; };

struct StaticOrder {
    int nM, nN, nwg, G, c;
    __host__ __device__ void init(int M, int N, int G_, int c_) { nM = M / BM; nN = N / BM; nwg = nM * nN; G = G_; c = c_; }
    __host__ __device__ bool next(int i, Unit& u) const {
        const long L = (long)i * G + c; if (L >= nwg) return false;
        int wgid = (int)L; { const int q = nwg / NXCD, r = nwg % NXCD, xcd = wgid % NXCD, off = wgid / NXCD; wgid = (xcd < r ? xcd * (q + 1) : r * (q + 1) + (xcd - r) * q) + off; }
        const int nig = WGM * nN, gid = wgid / nig, fm = gid * WGM, gsz = (nM - fm) < WGM ? (nM - fm) : WGM;
        u.pm = fm + ((wgid % nig) % gsz); u.pn = (wgid % nig) / gsz; return true;
    }
    __device__ __forceinline__ void a_ready(const Unit&) const {}
    __device__ __forceinline__ void done(const Unit&, bool) const {}
    __device__ __forceinline__ unsigned poll_issue(const Unit&) const { return 0u; }
    __device__ __forceinline__ void poll_check(unsigned) const {}
    __device__ __forceinline__ void a_ready_next(const Unit&) const {}
};
struct ChainOrder : StaticOrder {
    const unsigned* dep; unsigned need; unsigned* mine; unsigned** pendp; int lane; volatile PG8_LAS unsigned* okflag;
    int rot, rl, h0;
    __device__ __forceinline__ bool next(int i, Unit& u) const {
        if (G != 256 || nM != 130) return StaticOrder::next(i, u);
        const int x = c & 7, l = c >> 3, j = (l + rot) & 31, nmain = 16 * nN; int w = i * 32 + j;
        if (rl >= 0) {
            if (l == rl && i >= 9) return false;
            if ((l == h0 || l == h0 + 1) && i == 11) w = (9 + (l - h0)) * 32 + ((rl + rot) & 31); }
        if (w < nmain) { const int nig = 8 * nN, gid = w / nig; u.pm = 16 * x + 8 * gid + ((w % nig) & 7); u.pn = (w % nig) >> 3; return true; }
        const int sidx = x + 8 * (w - nmain); if (sidx >= 2 * nN) return false;
        u.pm = 128 + (sidx & 1); u.pn = sidx >> 1; return true;
    }
    __device__ __forceinline__ void publish(unsigned* p) const { if (lane == 0) __hip_atomic_fetch_add(p, 1u, __ATOMIC_RELAXED, __HIP_MEMORY_SCOPE_AGENT); }
    __device__ __forceinline__ void flush() const { if (*pendp) { asm volatile("s_waitcnt vmcnt(0)" ::: "memory"); publish(*pendp); *pendp = nullptr; } }
    __device__ __forceinline__ void wait_panel(const Unit& u) const {
        const unsigned* w = dep + 16 * u.pm; unsigned spins = 0;
        while ((unsigned)__builtin_amdgcn_readfirstlane(__hip_atomic_load(w, __ATOMIC_RELAXED, __HIP_MEMORY_SCOPE_AGENT)) < need) { __builtin_amdgcn_s_sleep(2); if (++spins > (1u << 20)) break; }
        __builtin_amdgcn_fence(__ATOMIC_ACQUIRE, "agent"); asm volatile("s_waitcnt vmcnt(0)" ::: "memory");
    }
    __device__ __forceinline__ void a_ready(const Unit& u) const {
        flush();
        if (dep) { if (threadIdx.x < 64) wait_panel(u); asm volatile("" ::: "memory"); __builtin_amdgcn_s_barrier(); asm volatile("" ::: "memory"); }
    }
    __device__ __forceinline__ unsigned poll_issue(const Unit& u) const { return (dep && threadIdx.x < 64) ? __hip_atomic_load(dep + 16 * u.pm, __ATOMIC_RELAXED, __HIP_MEMORY_SCOPE_AGENT) : 0u; }
    __device__ __forceinline__ void poll_check(unsigned v) const {
        if (dep && threadIdx.x < 64) { const bool ok = (unsigned)__builtin_amdgcn_readfirstlane(v) >= need; if (ok) asm volatile("buffer_inv sc1" ::: "memory"); if (lane == 0) okflag[0] = ok ? 1u : 0u; }
    }
    __device__ __forceinline__ void a_ready_next(const Unit& u) const {
        if (dep) {
            const bool ok = okflag[0] != 0u;
            if (!ok) { flush(); if (threadIdx.x < 64) wait_panel(u); }
            asm volatile("" ::: "memory"); __builtin_amdgcn_s_barrier(); asm volatile("" ::: "memory");
        }
    }
    __device__ __forceinline__ void done(const Unit& u, bool has_next) const {
        unsigned* m = mine ? mine + 16 * u.pm : nullptr;
        if (has_next) { flush(); *pendp = m; }
        else { asm volatile("s_waitcnt vmcnt(0)" ::: "memory"); if (*pendp) { publish(*pendp); *pendp = nullptr; } if (m) publish(m); }
    }
};
__device__ __forceinline__ void publish_prev(unsigned** pendp, int lane, float witness) {
    asm volatile("" :: "v"(witness) : "memory");
    if (*pendp) { if (lane == 0) __hip_atomic_fetch_add(*pendp, 1u, __ATOMIC_RELAXED, __HIP_MEMORY_SCOPE_AGENT); *pendp = nullptr; }
}
__device__ __forceinline__ unsigned cvt_pk_bf16(float lo, float hi) { unsigned r; asm volatile("v_cvt_pk_bf16_f32 %0, %1, %2" : "=v"(r) : "v"(lo), "v"(hi)); return r; }
typedef float f32x2 __attribute__((ext_vector_type(2)));
constexpr int TT = 33280, NP = 32768;
constexpr float RMS_EPS = 1e-6f, LOG2E = 1.4426950408889634f;
__device__ __forceinline__ float sigm(float x) { return __builtin_amdgcn_rcpf(1.0f + __builtin_amdgcn_exp2f(-LOG2E * x)); }
__device__ __forceinline__ float rs_from_ss(float ss) { return __builtin_amdgcn_rsqf(ss * (1.0f / 1024.0f) + RMS_EPS); }
__device__ __forceinline__ void st16_wt(void* p, u32x4 v) { asm volatile("global_store_dwordx4 %0, %1, off sc1\n\ts_nop 1" :: "v"(p), "v"(v) : "memory"); }
__device__ __forceinline__ void st16f_wt(void* p, f32x4 v) { asm volatile("global_store_dwordx4 %0, %1, off sc1\n\ts_nop 1" :: "v"(p), "v"(v) : "memory"); }
typedef unsigned u32x2w __attribute__((ext_vector_type(2)));
__device__ __forceinline__ void st8_wt(void* p, u32x2w v) { asm volatile("global_store_dwordx2 %0, %1, off sc1\n\ts_nop 1" :: "v"(p), "v"(v) : "memory"); }
__device__ __forceinline__ float ld_f32_ag(const float* p) { return *p; }
__device__ __forceinline__ f32x4 ld16f_ag(const float* p) { return *(const f32x4*)p; }
__device__ __forceinline__ u32x4 pack8(const f32x4& a, const f32x4& b) { u32x4 w; w.x = cvt_pk_bf16(a[0], a[1]); w.y = cvt_pk_bf16(a[2], a[3]); w.z = cvt_pk_bf16(b[0], b[1]); w.w = cvt_pk_bf16(b[2], b[3]); return w; }

template <int MODE> struct EpiGlu {
    static constexpr bool PERM = true, AFTER_DRAIN = false;
    bf16_t* O; int ldc; const float* ss; const float* bias; int nh; float* cp; float* cs; unsigned** pendp; int lane;
    __device__ __forceinline__ void operator()(const f32x4 (&acc)[2][2][4][2], const Unit& u, int wr, int wc, int fr, int fq) const {
        const int row0 = u.pm * BM + wr * 64 + fr, col0 = u.pn * 128 + wc * 32 + 8 * fq;
        f32x4 b0[2], b1[2];
#pragma unroll
        for (int n = 0; n < 2; ++n) { b0[n] = (MODE == 1) ? *(const f32x4*)(bias + col0 + 4 * n) : (f32x4){0.f, 0.f, 0.f, 0.f}; b1[n] = (MODE == 1) ? *(const f32x4*)(bias + nh + col0 + 4 * n) : (f32x4){0.f, 0.f, 0.f, 0.f}; }
        float rsv[2][4];
#pragma unroll
        for (int ai = 0; ai < 2; ++ai)
#pragma unroll
            for (int m = 0; m < 4; ++m) rsv[ai][m] = ld_f32_ag(ss + row0 + ai * HALF + m * 16);
        publish_prev(pendp, lane, rsv[1][3]);
#pragma unroll
        for (int ai = 0; ai < 2; ++ai)
#pragma unroll
            for (int m = 0; m < 4; ++m) { const int row = row0 + ai * HALF + m * 16; const float rs = rs_from_ss(rsv[ai][m]); f32x4 o[2];
#pragma unroll
                for (int n = 0; n < 2; ++n) { const f32x4 v0 = acc[ai][0][m][n] * rs + b0[n], v1 = acc[ai][1][m][n] * rs + b1[n];
                    const f32x4 sx = (MODE == 0) ? v0 : v1, tt = sx * (-LOG2E); f32x4 dd;
#pragma unroll
                    for (int i = 0; i < 4; ++i) dd[i] = __builtin_amdgcn_exp2f(tt[i]);
                    dd = dd + 1.0f;
#pragma unroll
                    for (int i = 0; i < 4; ++i) dd[i] = __builtin_amdgcn_rcpf(dd[i]);
                    o[n] = (MODE == 0) ? (v0 * dd) * v1 : v0 * dd; }
                st16_wt(O + (size_t)row * ldc + col0, pack8(o[0], o[1]));
                if (MODE == 1) { float* dst = nullptr;
                    if (row < NP) { const int pos = row & 16383, b = row >> 14; if (pos >= 16354) dst = cp + ((size_t)(b * 30 + pos - 16354)) * 1024 + col0; }
                    else { const int i = (row - NP) & 63, s = (row - NP) >> 6; if (i >= 34) dst = cs + ((size_t)(s * 30 + i - 34)) * 1024 + col0; }
                    if (dst) { *(f32x4*)dst = o[0]; *(f32x4*)(dst + 4) = o[1]; } }
            }
    }
};
struct EpiRes {
    static constexpr bool PERM = false, AFTER_DRAIN = false;
    float* X; bf16_t* XB; float* ssout; const float* bias; float alpha; unsigned** pendp; int lane; const float* Xin0; const float* Xin1;
    __device__ __forceinline__ void operator()(const f32x4 (&acc)[2][2][4][2], const Unit& u, int wr, int wc, int fr, int fq) const {
        typedef unsigned u32x2v __attribute__((ext_vector_type(2)));
        const int row0 = u.pm * BM + wr * 64 + fr, col0 = u.pn * BM + wc * 32 + 4 * fq;
        f32x4 bv[2][2];
#pragma unroll
        for (int bj = 0; bj < 2; ++bj)
#pragma unroll
            for (int n = 0; n < 2; ++n) bv[bj][n] = bias ? *(const f32x4*)(bias + col0 + bj * HALF + n * 16) : (f32x4){0.f, 0.f, 0.f, 0.f};
        f32x4 xr[3][2][2];
#pragma unroll
        for (int gi = 0; gi < 2; ++gi)
#pragma unroll
            for (int bj = 0; bj < 2; ++bj)
#pragma unroll
                for (int n = 0; n < 2; ++n) { const int rr = row0 + (gi >> 2) * HALF + (gi & 3) * 16; const float* rb = Xin0 ? (rr < NP ? Xin0 + (size_t)rr * 1024 : Xin1 + (size_t)(rr - NP) * 1024) : X + (size_t)rr * 1024; xr[gi][bj][n] = ld16f_ag(rb + col0 + bj * HALF + n * 16); }
#pragma unroll
        for (int gi = 0; gi < 8; ++gi) { const int ai = gi >> 2, m = gi & 3; const int row = row0 + ai * HALF + m * 16; const size_t off = (size_t)row * 1024 + col0; float s = 0.f;
            if (gi < 6) { const int ai2 = (gi + 2) >> 2, m2 = (gi + 2) & 3; const int rr = row0 + ai2 * HALF + m2 * 16; const float* rb = Xin0 ? (rr < NP ? Xin0 + (size_t)rr * 1024 : Xin1 + (size_t)(rr - NP) * 1024) : X + (size_t)rr * 1024;
#pragma unroll
                for (int bj = 0; bj < 2; ++bj)
#pragma unroll
                    for (int n = 0; n < 2; ++n) xr[(gi + 2) % 3][bj][n] = ld16f_ag(rb + col0 + bj * HALF + n * 16); }
            f32x4 xc[2][2];
#pragma unroll
            for (int bj = 0; bj < 2; ++bj)
#pragma unroll
                for (int n = 0; n < 2; ++n) xc[bj][n] = xr[gi % 3][bj][n];
            if (gi == 0) publish_prev(pendp, lane, xc[1][1][3]);
#pragma unroll
            for (int bj = 0; bj < 2; ++bj)
#pragma unroll
                for (int n = 0; n < 2; ++n) { f32x4 x = xc[bj][n] + (acc[ai][bj][m][n] + bv[bj][n]) * alpha; st16f_wt(X + off + bj * HALF + n * 16, x);
                    if (XB) { u32x2w w; w.x = cvt_pk_bf16(x[0], x[1]); w.y = cvt_pk_bf16(x[2], x[3]); st8_wt(XB + off + bj * HALF + n * 16, w); }
                    s += (x[0] * x[0] + x[1] * x[1]) + (x[2] * x[2] + x[3] * x[3]); }
            if (ssout) { s += __shfl_xor(s, 16); s += __shfl_xor(s, 32); if (fq == 0) unsafeAtomicAdd(ssout + row, s); } }
    }
};
struct EpiQK {
    static constexpr bool PERM = true, AFTER_DRAIN = false;
    bf16_t* Q; bf16_t* Kb; const float* ss; const float* qg; const float* kg; float* kp; float* ks;
    __device__ __forceinline__ void operator()(const f32x4 (&acc)[2][2][4][2], const Unit& u, int wr, int wc, int fr, int fq) const {
        const int row0 = u.pm * BM + wr * 64 + fr; const bool isK = u.pn >= 4; const int head = 4 * (u.pn & 3) + wc;
        const float gs = isK ? 1.0f : 0.125f * LOG2E; const float* gp = isK ? kg : qg; bf16_t* dstb = isK ? Kb : Q;
        f32x4 g[2][2];
#pragma unroll
        for (int bj = 0; bj < 2; ++bj)
#pragma unroll
            for (int n = 0; n < 2; ++n) g[bj][n] = *(const f32x4*)(gp + 32 * bj + 8 * fq + 4 * n) * gs;
#pragma unroll
        for (int ai = 0; ai < 2; ++ai)
#pragma unroll
            for (int m = 0; m < 4; ++m) { const int row = row0 + ai * HALF + m * 16; const float rs = rs_from_ss(ss[row]); f32x4 v[2][2]; float sq = 0.f;
#pragma unroll
                for (int bj = 0; bj < 2; ++bj)
#pragma unroll
                    for (int n = 0; n < 2; ++n) { v[bj][n] = acc[ai][bj][m][n] * rs; sq += (v[bj][n][0] * v[bj][n][0] + v[bj][n][1] * v[bj][n][1]) + (v[bj][n][2] * v[bj][n][2] + v[bj][n][3] * v[bj][n][3]); }
                sq += __shfl_xor(sq, 16); sq += __shfl_xor(sq, 32);
                const float rn = __builtin_amdgcn_rsqf(sq * (1.0f / 64.0f) + RMS_EPS);
                float* kd = nullptr;
                if (isK) { if (row < NP) { const int pos = row & 16383, b = row >> 14; if (pos >= 15872) kd = kp + ((size_t)(b * 512 + pos - 15872)) * 1024 + head * 64 + 8 * fq; }
                           else kd = ks + (size_t)(row - NP) * 1024 + head * 64 + 8 * fq; }
#pragma unroll
                for (int bj = 0; bj < 2; ++bj) { const f32x4 o0 = v[bj][0] * rn * g[bj][0], o1 = v[bj][1] * rn * g[bj][1];
                    *(u32x4*)(dstb + ((size_t)((row >> 5) * 16 + head)) * 2048 + ((4 * bj + fq) * 32 + (row & 31)) * 8) = pack8(o0, o1);
                    if (kd) { *(f32x4*)(kd + 32 * bj) = o0; *(f32x4*)(kd + 32 * bj + 4) = o1; } }
            }
    }
};
struct EpiVT {
    static constexpr bool PERM = true, AFTER_DRAIN = false;
    bf16_t* VT; const float* ss; float* vp; float* vs;
    __device__ __forceinline__ void operator()(const f32x4 (&acc)[2][2][4][2], const Unit& u, int wr, int wc, int fr, int fq) const {
        const int f0 = u.pm * BM + wr * 64 + fr;
        f32x4 rs[2][2];
#pragma unroll
        for (int bj = 0; bj < 2; ++bj)
#pragma unroll
            for (int n = 0; n < 2; ++n) { const f32x4 s4 = *(const f32x4*)(ss + u.pn * BM + bj * HALF + wc * 32 + 8 * fq + 4 * n);
#pragma unroll
                for (int i = 0; i < 4; ++i) rs[bj][n][i] = rs_from_ss(s4[i]); }
#pragma unroll
        for (int ai = 0; ai < 2; ++ai)
#pragma unroll
            for (int m = 0; m < 4; ++m) { const int f = f0 + ai * HALF + m * 16;
#pragma unroll
                for (int bj = 0; bj < 2; ++bj) { const int tokb = u.pn * BM + bj * HALF + wc * 32, tok0 = tokb + 8 * fq;
                    const f32x4 o0 = acc[ai][bj][m][0] * rs[bj][0], o1 = acc[ai][bj][m][1] * rs[bj][1];
                    { typedef unsigned u32x2v __attribute__((ext_vector_type(2))); const int hh = f >> 6, db = (f >> 5) & 1, dd = f & 31, sl = fq >> 1, half = fq & 1;
                      bf16_t* vb = VT + ((size_t)((tokb >> 5) * 16 + hh)) * 2048 + (((db * 2 + sl) * 2) * 32 + dd) * 8 + 4 * half;
                      u32x2v w0, w1; w0.x = cvt_pk_bf16(o0[0], o0[1]); w0.y = cvt_pk_bf16(o0[2], o0[3]); w1.x = cvt_pk_bf16(o1[0], o1[1]); w1.y = cvt_pk_bf16(o1[2], o1[3]);
                      *(u32x2v*)vb = w0; *(u32x2v*)(vb + 256) = w1; }
                    const bool kept = (tokb < NP) ? ((tokb & 16383) >= 15872) : true;
                    if (kept) { float* d = (tok0 < NP) ? vp + ((size_t)((tok0 >> 14) * 512 + (tok0 & 16383) - 15872)) * 1024 + f : vs + (size_t)(tok0 - NP) * 1024 + f;
#pragma unroll
                        for (int i = 0; i < 4; ++i) { d[(size_t)i * 1024] = o0[i]; d[(size_t)(4 + i) * 1024] = o1[i]; } } }
            }
    }
};
template <class Epi, class Sched, bool ALIGN_EPI = false, bool SP2 = false, bool A_SC1 = false>
__device__ __forceinline__ void gemm_phase(PG8_LAS unsigned char* lds, const Gemm g, const Sched& S, const Epi& E, const int tid) {
    const int wid = __builtin_amdgcn_readfirstlane(tid >> 6), lane = tid & 63, wr = wid >> 2, wc = wid & 3, fr = lane & 15, fq = lane >> 4;
    const int K = g.K, nt = K / BK;
    unsigned voffA[2], voffB[2];
#pragma unroll
    for (int i = 0; i < 2; ++i) { int R, C; stage_rc(tid * 16 + i * 8192, R, C); const int Rb = Epi::PERM ? ((R & ~31) + perm32(R & 31)) : R;
        voffA[i] = (unsigned)(R * K + C) * 2u; voffB[i] = (unsigned)(Rb * K + C) * 2u; }
    const size_t kstep = (size_t)(BK * 2);
    const size_t hstep = (size_t)HALF * K * 2;
    const size_t tstep = 2 * hstep;
    const unsigned ldsw = (unsigned)wid * 1024u;
    const int aoff = lds_byte(wr * 64 + fr, fq * 8), boff = lds_byte(wc * 32 + fr, fq * 8);
#define PG8_SA(b, h) (((b) * 2 + (h)) * HTB)
#define PG8_SB(b, h) ((4 + (b) * 2 + (h)) * HTB)
#define PG8_STAGE(bufoff, gbase, voff) do { _Pragma("unroll") for (int _i = 0; _i < 2; ++_i) \
        __builtin_amdgcn_global_load_lds((const unsigned*)((const char*)(gbase) + (voff)[_i]), (PG8_LAS unsigned*)(lds + (bufoff) + ldsw + _i * 8192), 16, 0, 0); } while (0)
#define PG8_STAGEA(bufoff, gbase, voff) do { _Pragma("unroll") for (int _i = 0; _i < 2; ++_i) \
        __builtin_amdgcn_global_load_lds((const unsigned*)((const char*)(gbase) + (voff)[_i]), (PG8_LAS unsigned*)(lds + (bufoff) + ldsw + _i * 8192), 16, 0, A_SC1 ? 16 : 0); } while (0)
#define PG8_LDA(dst, b, h) do { _Pragma("unroll") for (int m = 0; m < 4; ++m) _Pragma("unroll") for (int k = 0; k < 2; ++k) dst[m][k] = *(const PG8_LAS bf16x8*)(lds + PG8_SA(b, h) + aoff + m * 2048 + k * 1024); } while (0)
#define PG8_LDB(dst, b, h) do { _Pragma("unroll") for (int n = 0; n < 2; ++n) _Pragma("unroll") for (int k = 0; k < 2; ++k) dst[n][k] = *(const PG8_LAS bf16x8*)(lds + PG8_SB(b, h) + boff + n * 2048 + k * 1024); } while (0)
#define PG8_MMA(ai, bj, At, Bt) do { __builtin_amdgcn_s_setprio(1); _Pragma("unroll") for (int m = 0; m < 4; ++m) _Pragma("unroll") for (int n = 0; n < 2; ++n) _Pragma("unroll") for (int k = 0; k < 2; ++k) \
        acc[ai][bj][m][n] = __builtin_amdgcn_mfma_f32_16x16x32_bf16(Bt[n][k], At[m][k], acc[ai][bj][m][n], 0, 0, 0); __builtin_amdgcn_s_setprio(0); } while (0)
#define PG8_WAIT_V(n) asm volatile("s_waitcnt vmcnt(" #n ")" ::: "memory")
#define PG8_WAIT_L(n) asm volatile("s_waitcnt lgkmcnt(" #n ")" ::: "memory")
#define PG8_BAR __builtin_amdgcn_s_barrier()
#define PG8_SCHED __builtin_amdgcn_sched_barrier(0)
    Unit cur, nxt; int ui = 0;
    if (!S.next(0, cur)) return;
    f32x4 acc[2][2][4][2];
#pragma unroll
    for (int a = 0; a < 2; ++a)
#pragma unroll
        for (int b = 0; b < 2; ++b)
#pragma unroll
            for (int m = 0; m < 4; ++m)
#pragma unroll
                for (int n = 0; n < 2; ++n) acc[a][b][m][n] = (f32x4){0.f, 0.f, 0.f, 0.f};
    bf16x8 At[4][2], B0[2][2], B1[2][2];
    const char* cA = (const char*)g.A + (size_t)cur.pm * tstep; const char* cB = (const char*)g.Bt + (size_t)cur.pn * tstep;
    S.a_ready(cur);
    if constexpr (SP2) {
        PG8_STAGE(PG8_SB(0, 0), cB, voffB); PG8_STAGE(PG8_SB(0, 1), cB + hstep, voffB); PG8_STAGEA(PG8_SA(0, 0), cA, voffA); PG8_STAGEA(PG8_SA(0, 1), cA + hstep, voffA);
        if (wr == 1) PG8_BAR;
        PG8_WAIT_V(2); PG8_BAR;
        PG8_STAGE(PG8_SB(1, 0), cB + kstep, voffB); PG8_STAGEA(PG8_SA(1, 0), cA + kstep, voffA); PG8_STAGE(PG8_SB(1, 1), cB + hstep + kstep, voffB);
        PG8_WAIT_V(6); PG8_BAR;
    } else {
        PG8_STAGE(PG8_SB(0, 0), cB, voffB); PG8_STAGEA(PG8_SA(0, 0), cA, voffA); PG8_STAGE(PG8_SB(0, 1), cB + hstep, voffB); PG8_STAGEA(PG8_SA(0, 1), cA + hstep, voffA);
        if (wr == 1) PG8_BAR;
        PG8_WAIT_V(4); PG8_BAR;
        PG8_STAGE(PG8_SB(1, 0), cB + kstep, voffB); PG8_STAGEA(PG8_SA(1, 0), cA + kstep, voffA); PG8_STAGE(PG8_SB(1, 1), cB + hstep + kstep, voffB);
        PG8_WAIT_V(6); PG8_BAR;
    }
    for (;;) {
        const bool has_next = S.next(ui + 1, nxt);
        const char* nA = has_next ? (const char*)g.A + (size_t)nxt.pm * tstep : cA; const char* nB = has_next ? (const char*)g.Bt + (size_t)nxt.pn * tstep : cB;
        unsigned pollv = 0u;
        for (int t = 0; t < nt; t += 2) {
            const bool last = (t == nt - 2);
            const char* a1 = cA + (size_t)(t + 1) * kstep;
            const char* a2 = last ? nA : cA + (size_t)(t + 2) * kstep; const char* b2 = last ? nB : cB + (size_t)(t + 2) * kstep;
            const char* a3 = a2 + kstep; const char* b3 = b2 + kstep;
            if (has_next) { if (t == nt - 6) pollv = S.poll_issue(nxt); else if (t == nt - 4) S.poll_check(pollv); }
            if (last && has_next) S.a_ready_next(nxt);
            if constexpr (SP2) {
            PG8_LDB(B0, 0, 0); PG8_LDB(B1, 0, 1); PG8_SCHED; PG8_LDA(At, 0, 0); PG8_STAGEA(PG8_SA(1, 1), a1 + hstep, voffA);
            PG8_WAIT_V(8); PG8_WAIT_L(0); PG8_BAR; PG8_MMA(0, 0, At, B0); PG8_MMA(0, 1, At, B1); PG8_BAR; PG8_SCHED;
            PG8_LDA(At, 0, 1); PG8_STAGE(PG8_SB(0, 0), b2, voffB); PG8_STAGE(PG8_SB(0, 1), b2 + hstep, voffB); PG8_STAGEA(PG8_SA(0, 0), a2, voffA);
            PG8_WAIT_V(8); PG8_WAIT_L(0); PG8_BAR; PG8_MMA(1, 0, At, B0); PG8_MMA(1, 1, At, B1); PG8_BAR; PG8_SCHED;
            PG8_LDB(B0, 1, 0); PG8_LDB(B1, 1, 1); PG8_SCHED; PG8_LDA(At, 1, 0); PG8_STAGEA(PG8_SA(0, 1), a2 + hstep, voffA);
            PG8_WAIT_V(8); PG8_WAIT_L(0); PG8_BAR; PG8_MMA(0, 0, At, B0); PG8_MMA(0, 1, At, B1); PG8_BAR; PG8_SCHED;
            PG8_LDA(At, 1, 1); PG8_STAGE(PG8_SB(1, 0), b3, voffB); PG8_STAGE(PG8_SB(1, 1), b3 + hstep, voffB); PG8_STAGEA(PG8_SA(1, 0), a3, voffA);
            PG8_WAIT_V(8); PG8_WAIT_L(0); PG8_BAR; PG8_MMA(1, 0, At, B0); PG8_MMA(1, 1, At, B1); PG8_BAR; PG8_SCHED;
            } else {
            PG8_LDB(B0, 0, 0); PG8_SCHED; PG8_LDA(At, 0, 0); PG8_STAGEA(PG8_SA(1, 1), a1 + hstep, voffA);
            PG8_WAIT_L(8); PG8_BAR; PG8_WAIT_L(0); PG8_MMA(0, 0, At, B0); PG8_BAR; PG8_SCHED;
            PG8_LDB(B1, 0, 1); PG8_STAGE(PG8_SB(0, 0), b2, voffB);
            PG8_BAR; PG8_WAIT_L(0); PG8_MMA(0, 1, At, B1); PG8_BAR;
            PG8_LDA(At, 0, 1); PG8_STAGEA(PG8_SA(0, 0), a2, voffA);
            PG8_BAR; PG8_WAIT_L(0); PG8_MMA(1, 0, At, B0); PG8_BAR; PG8_SCHED;
            PG8_STAGE(PG8_SB(0, 1), b2 + hstep, voffB);
            PG8_WAIT_V(6); PG8_BAR; PG8_MMA(1, 1, At, B1); PG8_BAR;
            PG8_LDB(B0, 1, 0); PG8_SCHED; PG8_LDA(At, 1, 0); PG8_STAGEA(PG8_SA(0, 1), a2 + hstep, voffA);
            PG8_WAIT_L(8); PG8_BAR; PG8_WAIT_L(0); PG8_MMA(0, 0, At, B0); PG8_BAR; PG8_SCHED;
            PG8_LDB(B1, 1, 1); PG8_STAGE(PG8_SB(1, 0), b3, voffB);
            PG8_BAR; PG8_WAIT_L(0); PG8_MMA(0, 1, At, B1); PG8_BAR;
            PG8_LDA(At, 1, 1); PG8_STAGEA(PG8_SA(1, 0), a3, voffA);
            PG8_BAR; PG8_WAIT_L(0); PG8_MMA(1, 0, At, B0); PG8_BAR; PG8_SCHED;
            PG8_STAGE(PG8_SB(1, 1), b3 + hstep, voffB);
            PG8_WAIT_V(6); PG8_BAR; PG8_MMA(1, 1, At, B1); PG8_BAR;
            }
        }
        if constexpr (ALIGN_EPI) { if (wr == 0) PG8_BAR; }
        if constexpr (!Epi::AFTER_DRAIN) { E(acc, cur, wr, wc, fr, fq); S.done(cur, has_next); }
        if (!has_next) break;
#pragma unroll
        for (int a = 0; a < 2; ++a)
#pragma unroll
            for (int b = 0; b < 2; ++b)
#pragma unroll
                for (int m = 0; m < 4; ++m)
#pragma unroll
                    for (int n = 0; n < 2; ++n) acc[a][b][m][n] = (f32x4){0.f, 0.f, 0.f, 0.f};
        cur = nxt; cA = nA; cB = nB; ++ui;
        if constexpr (ALIGN_EPI) { if (wr == 1) PG8_BAR; }
    }
    PG8_WAIT_V(0);
    if constexpr (!ALIGN_EPI) { if (wr == 0) PG8_BAR; }
    PG8_BAR;
    if constexpr (Epi::AFTER_DRAIN) { E.fused(acc, cur, wr, wc, fr, fq, lds, wid, lane); S.done(cur, false); }
#undef PG8_SA
#undef PG8_SB
#undef PG8_STAGE
#undef PG8_STAGEA
#undef PG8_LDA
#undef PG8_LDB
#undef PG8_MMA
#undef PG8_WAIT_V
#undef PG8_WAIT_L
#undef PG8_BAR
#undef PG8_SCHED
}
}

#define LAS __attribute__((address_space(3)))
typedef unsigned short bf16;
typedef short bf16x8 __attribute__((ext_vector_type(8)));
typedef short s16x4 __attribute__((ext_vector_type(4)));
typedef float f32x4 __attribute__((ext_vector_type(4)));
typedef float f32x16 __attribute__((ext_vector_type(16)));
typedef unsigned u32x4 __attribute__((ext_vector_type(4)));
typedef unsigned u32x2 __attribute__((ext_vector_type(2)));
constexpr int TT = pg8::TT, NP = pg8::NP, D = 1024, FF = 2816;
constexpr float LOG2E = pg8::LOG2E;
constexpr size_t MiB = 1u << 20;
constexpr size_t WS_SS = 0, WS_WGU = 1 * MiB, WS_WD = 45 * MiB, WS_WQK = 67 * MiB, WS_WV = 71 * MiB, WS_WO = 73 * MiB, WS_WPW1 = 75 * MiB, WS_WPW2 = 79 * MiB;
constexpr size_t WS_KC = 81 * MiB, WS_VCT = 89 * MiB, WS_XB = 97 * MiB, WS_H = 162 * MiB, WS_Q = WS_H, WS_K = WS_H + 65 * MiB, WS_VT = WS_H + 130 * MiB, WS_O = 357 * MiB, WS_WDWT = 422 * MiB, WS_U = 423 * MiB, WS_END = 488 * MiB;
constexpr size_t WS_CNT = 800 * 1024;
constexpr int CNT_BANK = 130 * 16;
constexpr int LDS_BYTES = 147456, STAT_OFF = 131072;
#define LDS_WAIT() asm volatile("s_waitcnt lgkmcnt(0)" ::: "memory")
__device__ __forceinline__ unsigned pk2(float lo, float hi) { return pg8::cvt_pk_bf16(lo, hi); }
__device__ __forceinline__ float wave_sum(float v) {
#pragma unroll
    for (int o = 1; o < 64; o <<= 1) v += __shfl_xor(v, o);
    return v;
}
struct Args { const float* in[28]; float* out; unsigned char* ws; int ph_lo, ph_hi; };
typedef const __attribute__((address_space(4))) Args CArgs;

#define RLX_AGENT __ATOMIC_RELAXED, __HIP_MEMORY_SCOPE_AGENT
constexpr size_t WS_BAR = 900 * 1024;
constexpr int MISC_OFF = LDS_BYTES - 64;
#define XB_TMO      128
#define XB_XCNT(j)  (256  + 64 * (j))
#define XB_XSUB(j)  (1280 + 64 * (j))
#define XB_XGEN(j)  (2304 + 64 * (j))
#define XB_TOP      3328
#define XB_TOPGEN   3392
#define XCD_BAR_WORDS 3456
#define XB_SPIN_CAP (1u << 18)

__device__ __forceinline__ unsigned xb_ld(unsigned* p)              { return __hip_atomic_load(p, __ATOMIC_RELAXED, __HIP_MEMORY_SCOPE_AGENT); }
__device__ __forceinline__ unsigned xb_add(unsigned* p, unsigned v) { return __hip_atomic_fetch_add(p, v, __ATOMIC_RELAXED, __HIP_MEMORY_SCOPE_AGENT); }
__device__ __forceinline__ unsigned xb_xcc_id() { return (unsigned)__builtin_amdgcn_s_getreg((3 << 11) | 20) & 0xFu; }
#define XB_SPIN(cond, bar) do { unsigned _sp = 0; while (cond) { __builtin_amdgcn_s_sleep(1); \
    if ((++_sp & 255u) == 0u) { if (xb_ld(&(bar)[XB_TMO])) break; if (_sp > XB_SPIN_CAP) { atomicAdd(&(bar)[XB_TMO], 1u); break; } } } } while (0)

struct XcdBarrier {
    unsigned* bar; unsigned x;
    volatile LAS unsigned* st;
};

__device__ __forceinline__ XcdBarrier xcd_barrier_post(unsigned* bar, volatile LAS unsigned* st) {
    XcdBarrier b; b.bar = bar; b.x = xb_xcc_id(); b.st = st;
    if (threadIdx.x == 0) (void)xb_add(&bar[XB_XCNT(b.x)], 1u);
    return b;
}
__device__ __forceinline__ void xcd_barrier_complete(unsigned* bar, unsigned x, unsigned& nloc, unsigned& nx) {
    const unsigned G = gridDim.x * gridDim.y * gridDim.z;
    unsigned sum, cnt, mine, sp = 0u;
    for (;;) {
        sum = 0u; cnt = 0u; mine = 0u;
#pragma unroll
        for (unsigned j = 0; j < 16; ++j) { const unsigned c = xb_ld(&bar[XB_XCNT(j)]); sum += c; cnt += (c > 0u) ? 1u : 0u; mine = (j == x) ? c : mine; }
        if (sum == G) break;
        __builtin_amdgcn_s_sleep(1);
        if ((++sp & 255u) == 0u) { if (xb_ld(&bar[XB_TMO])) break; if (sp > XB_SPIN_CAP) { atomicAdd(&bar[XB_TMO], 1u); break; } }
    }
    nloc = mine > 0u ? mine : 1u; nx = cnt > 0u ? cnt : 1u;
}

__device__ __forceinline__ void xcd_barrier(const XcdBarrier& b) {
    asm volatile("s_waitcnt vmcnt(0)" ::: "memory");
    __syncthreads();
    if (threadIdx.x == 0) {
        unsigned* bar = b.bar;
        __builtin_amdgcn_s_waitcnt(0);
        unsigned nloc = b.st[0], nx = b.st[1];
        if (nloc == 0u) { xcd_barrier_complete(bar, b.x, nloc, nx); b.st[0] = nloc; b.st[1] = nx; }
        const unsigned old = xb_add(&bar[XB_XSUB(b.x)], 1u);
        const unsigned gen = old / nloc;
        if (old + 1u == (gen + 1u) * nloc) {
            __builtin_amdgcn_fence(__ATOMIC_RELEASE, "agent");
            asm volatile("s_waitcnt vmcnt(0)" ::: "memory");
            const unsigned og = xb_add(&bar[XB_TOP], 1u);
            const unsigned tg = og / nx;
            if (og + 1u == (tg + 1u) * nx) xb_add(&bar[XB_TOPGEN], 1u);
            else XB_SPIN(xb_ld(&bar[XB_TOPGEN]) == tg, bar);
            __builtin_amdgcn_fence(__ATOMIC_ACQUIRE, "agent");
            xb_add(&bar[XB_XGEN(b.x)], 1u);
            asm volatile("s_waitcnt vmcnt(0)" ::: "memory");
        } else {
            XB_SPIN(xb_ld(&bar[XB_XGEN(b.x)]) == gen, bar);
            __builtin_amdgcn_fence(__ATOMIC_ACQUIRE, "agent");
            asm volatile("s_waitcnt vmcnt(0)" ::: "memory");
        }
    }
    __syncthreads();
}

struct TItem { const float* W; const float* gain; bf16* dst; int ld, K, k0, n0, drow0; };
__device__ __forceinline__ TItem decode_item(CArgs* ap, unsigned char* ws, int it) {
    int j;
    if (it < 12 * 1408) { j = it / 1408; it -= j * 1408; }
    else { it -= 12 * 1408; if (it < 1024) j = 12; else { it -= 1024; j = 13 + (it >> 9); it &= 511; } }
    TItem I; I.gain = nullptr; int ncols, map;
    if (j < 8) { const int F = j & 3, L = F >> 1, wh = F & 1, up = j >> 2; I.W = ap->in[(wh ? 10 : 6) + up] + (size_t)L * D * FF; I.gain = ap->in[wh ? 9 : 5] + L * D; I.ld = FF; I.K = D; ncols = FF; map = 1 + up; I.dst = (bf16*)(ws + WS_WGU) + (size_t)F * 2 * FF * D; }
    else if (j < 12) { const int F = j - 8, L = F >> 1, wh = F & 1; I.W = ap->in[wh ? 12 : 8] + (size_t)L * FF * D; I.ld = D; I.K = FF; ncols = D; map = 0; I.dst = (bf16*)(ws + WS_WD) + (size_t)F * D * FF; }
    else if (j == 12) { I.W = ap->in[14]; I.ld = 3 * D; I.K = D; ncols = 2 * D; map = 3; I.dst = (bf16*)(ws + WS_WQK); I.gain = ap->in[13]; }
    else if (j == 13) { I.W = ap->in[14] + 2 * D; I.ld = 3 * D; I.K = D; ncols = D; map = 0; I.dst = (bf16*)(ws + WS_WV); I.gain = ap->in[13]; }
    else if (j == 14) { I.W = ap->in[18]; I.ld = D; I.K = D; ncols = D; map = 0; I.dst = (bf16*)(ws + WS_WO); }
    else if (j == 15 || j == 16) { I.W = ap->in[20] + (j - 15) * D; I.ld = 2 * D; I.K = D; ncols = D; map = j - 14; I.dst = (bf16*)(ws + WS_WPW1); I.gain = ap->in[19]; }
    else { I.W = ap->in[26]; I.ld = D; I.K = D; ncols = D; map = 0; I.dst = (bf16*)(ws + WS_WPW2); }
    const int nblk = ncols / 32, kb = it / nblk, nb = it % nblk, n0 = nb * 32;
    if (map == 0) I.drow0 = n0; else if (map == 1) I.drow0 = 256 * (n0 >> 7) + (n0 & 127); else if (map == 2) I.drow0 = 256 * (n0 >> 7) + 128 + (n0 & 127);
    else { const int lb = (n0 & 255) >> 5; I.drow0 = (n0 & ~255) + 32 * (4 * (lb & 1) + (lb >> 1)); }
    I.k0 = kb * 64; I.n0 = n0; return I;
}
__device__ __forceinline__ void item_load(const TItem& I, int lane, f32x4 (&v)[8], float (&g)[8]) {
    const int n4 = lane & 7, kr = lane >> 3; const float* gp = I.gain ? I.gain : I.W;
#pragma unroll
    for (int i = 0; i < 8; ++i) { v[i] = *(const f32x4*)(I.W + (size_t)(I.k0 + 8 * i + kr) * I.ld + I.n0 + 4 * n4); g[i] = gp[I.k0 + 8 * i + kr]; }
}
__device__ __forceinline__ void item_store(const TItem& I, int lane, const f32x4 (&v)[8], const float (&g)[8], LAS float* scr) {
    const int n4 = lane & 7, kr = lane >> 3; const bool hg = I.gain != nullptr;
#pragma unroll
    for (int i = 0; i < 8; ++i) { const int kk = 8 * i + kr; const float gsc = hg ? g[i] : 1.0f;
#pragma unroll
        for (int e = 0; e < 4; ++e) scr[kk * 33 + 4 * n4 + e] = v[i][e] * gsc; }
    LDS_WAIT(); asm volatile("" ::: "memory");
    const int c = lane & 7;
#pragma unroll
    for (int j = 0; j < 4; ++j) { const int n = (lane >> 3) + 8 * j; const LAS float* s = scr + (8 * c) * 33 + n;
        u32x4 o; o.x = pk2(s[0 * 33], s[1 * 33]); o.y = pk2(s[2 * 33], s[3 * 33]); o.z = pk2(s[4 * 33], s[5 * 33]); o.w = pk2(s[6 * 33], s[7 * 33]);
        *(u32x4*)(I.dst + (size_t)(I.drow0 + n) * I.K + I.k0 + 8 * c) = o; }
    LDS_WAIT(); asm volatile("" ::: "memory");
}
__device__ __forceinline__ void p0_prologue(CArgs* ap, LAS unsigned char* lds, int gw, int ngw, int wave, int lane) {
    unsigned char* ws = ap->ws;
    LAS float* scr = (LAS float*)(lds + wave * 8704);
    constexpr int NIT = 12 * 1408 + 1024 + 512 + 512 + 512 + 512 + 512;
    if (gw < NIT) {
        TItem cur = decode_item(ap, ws, gw); f32x4 v[8]; float g[8]; item_load(cur, lane, v, g);
        for (int it0 = gw; it0 < NIT; it0 += ngw) {
            const int nx = (it0 + ngw < NIT) ? it0 + ngw : it0;
            const TItem nxt = decode_item(ap, ws, nx); f32x4 vn[8]; float gn[8]; item_load(nxt, lane, vn, gn);
            item_store(cur, lane, v, g, scr);
            cur = nxt;
#pragma unroll
            for (int i = 0; i < 8; ++i) { v[i] = vn[i]; g[i] = gn[i]; }
        }
    }
    { const float* wd = ap->in[22]; float* wt = (float*)(ws + WS_WDWT); for (int e = gw * 64 + lane; e < 31 * 1024; e += ngw * 64) { const int k = e >> 10, c = e & 1023; wt[(c >> 1) * 64 + 2 * k + (c & 1)] = wd[e]; } }
    { const float* ck = ap->in[2]; const float* cv = ap->in[3]; bf16* kc = (bf16*)(ws + WS_KC); bf16* vc = (bf16*)(ws + WS_VCT); const int nthr = ngw * 64;
      for (int e = gw * 64 + lane; e < 8 * 512 * 16 * 8; e += nthr) { const int c8 = e & 7, h = (e >> 3) & 15, pos = (e >> 7) & 511, s_ = e >> 16;
          const float* src = ck + ((size_t)(s_ * 512 + pos)) * 1024 + h * 64 + c8 * 8; const f32x4 x0 = *(const f32x4*)src, x1 = *(const f32x4*)(src + 4);
          *(u32x4*)(kc + ((size_t)((s_ * 16 + (pos >> 5)) * 16 + h)) * 2048 + (c8 * 32 + (pos & 31)) * 8) = pg8::pack8(x0, x1); }
      for (int e = gw * 64 + lane; e < 8 * 16 * 16 * 8 * 32; e += nthr) { const int d = e & 31, cvi = (e >> 5) & 7, h = (e >> 8) & 15, tbc = (e >> 12) & 15, s_ = e >> 16;
          const int db = cvi >> 2, sl = (cvi >> 1) & 1, kg = cvi & 1; const float* src = cv + ((size_t)(s_ * 512 + 32 * tbc + 16 * sl + 4 * kg)) * 1024 + h * 64 + 32 * db + d; float x[8];
#pragma unroll
          for (int j = 0; j < 8; ++j) x[j] = src[(size_t)((j & 3) + 8 * (j >> 2)) * 1024];
          u32x4 o; o.x = pk2(x[0], x[1]); o.y = pk2(x[2], x[3]); o.z = pk2(x[4], x[5]); o.w = pk2(x[6], x[7]);
          *(u32x4*)(vc + ((size_t)((s_ * 16 + tbc) * 16 + h)) * 2048 + (cvi * 32 + d) * 8) = o; } }
    { bf16* XB = (bf16*)(ws + WS_XB); float* ss0 = (float*)(ws + WS_SS);
      for (int t2 = gw; t2 < TT / 2; t2 += ngw) { f32x4 v[2][4];
#pragma unroll
          for (int r = 0; r < 2; ++r) { const int t = 2 * t2 + r; const float* src = (t < NP) ? ap->in[0] + (size_t)t * D : ap->in[1] + (size_t)(t - NP) * D;
#pragma unroll
              for (int j = 0; j < 4; ++j) v[r][j] = *(const f32x4*)(src + 4 * lane + 256 * j); }
#pragma unroll
          for (int r = 0; r < 2; ++r) { const int t = 2 * t2 + r; float s = 0.f;
#pragma unroll
              for (int j = 0; j < 4; ++j) { const f32x4 x = v[r][j];
                  u32x2 w; w.x = pk2(x[0], x[1]); w.y = pk2(x[2], x[3]); *(u32x2*)(XB + (size_t)t * D + 4 * lane + 256 * j) = w; s += (x[0] * x[0] + x[1] * x[1]) + (x[2] * x[2] + x[3] * x[3]); }
              s = wave_sum(s); if (lane == 0) ss0[t] = s; } } }
}

__device__ __forceinline__ int crow(int r, int hi) { return (r & 3) + 8 * (r >> 2) + 4 * hi; }
__device__ __forceinline__ void attn_phase(LAS unsigned char* lds, const bf16* Q, const bf16* Kb, const bf16* VT, const bf16* Kc, const bf16* VcT, bf16* O, const float* relb, int gw, int ngw, int tid) {
    LAS float* tab = (LAS float*)lds;
    for (int e = tid; e < 16 * 257; e += 512) { const int h = e / 257, idx = e % 257; tab[h * 260 + idx] = (relb[idx * 16 + h] - relb[256 * 16 + h]) * LOG2E; }
    __syncthreads();
    const int lane = tid & 63, q = lane & 31, hi = lane >> 5;
    const bool xmap = (ngw == 2048);
    for (int it = 0, slot = gw; xmap ? (it < 4) : (slot < 8192); ++it, slot += ngw) {
      int unit0, unit1 = 0, nu = 1;
      if (xmap) { const int bxx = gw >> 3, x = bxx & 7, sl = ((bxx >> 3) << 3) + (gw & 7) + 256 * it, hh = 2 * x + (sl & 1), ci = sl >> 1;
          if (ci < 496) { const int b = ci / 248, c = 8 + (ci - b * 248); unit0 = ((b * 256 + c) << 4) | hh; }
          else if (ci < 504) { const int p = ci - 496, b = p >> 2, qq = p & 3; unit0 = ((b * 256 + qq) << 4) | hh; unit1 = ((b * 256 + 7 - qq) << 4) | hh; nu = 2; }
          else unit0 = 8192 + ((ci - 504) << 4) + hh;
      } else
      if (slot < 7936) { const int b = slot / 3968, rem = slot - b * 3968; unit0 = ((b * 256 + 8 + (rem >> 4)) << 4) | (rem & 15); }
      else if (slot < 8064) { const int p = slot - 7936, b = p >> 6, qq = (p >> 4) & 3, hh = p & 15; unit0 = ((b * 256 + qq) << 4) | hh; unit1 = ((b * 256 + 7 - qq) << 4) | hh; nu = 2; }
      else unit0 = 8192 + (slot - 8064);
      for (int ui = 0; ui < nu; ++ui) { const int unit = ui ? unit1 : unit0;
        const int h = unit & 15; int qrow0, tile_lo, sidx = 0; bool samp = false;
        if (unit < 8192) { const int c = (unit >> 4) & 255, b = unit >> 12; qrow0 = b * 16384 + c * 64; tile_lo = c < 8 ? 16 - 2 * c : 0; }
        else { sidx = (unit - 8192) >> 4; qrow0 = NP + 64 * sidx; samp = true; tile_lo = 0; }
        const int bandb = (qrow0 - 512) / 32;
#define ATT_LOAD(t, KF, VF) do { const bool uc = samp && (t) < 16; \
        const size_t blk_ = uc ? ((size_t)((sidx * 16 + (t)) * 16 + h)) * 2048 : ((size_t)((bandb + (t)) * 16 + h)) * 2048; \
        const bf16* kp_ = (uc ? Kc : Kb) + blk_ + (hi * 32 + q) * 8; const bf16* vp_ = (uc ? VcT : VT) + blk_ + (hi * 32 + q) * 8; \
        _Pragma("unroll") for (int d0 = 0; d0 < 4; ++d0) KF[d0] = *(const bf16x8*)(kp_ + d0 * 512); \
        _Pragma("unroll") for (int db = 0; db < 2; ++db) _Pragma("unroll") for (int s = 0; s < 2; ++s) VF[db][s] = *(const bf16x8*)(vp_ + (db * 2 + s) * 512); } while (0)
        bf16x8 Qf[2][4];
#pragma unroll
        for (int qb = 0; qb < 2; ++qb)
#pragma unroll
            for (int d0 = 0; d0 < 4; ++d0) Qf[qb][d0] = *(const bf16x8*)(Q + ((size_t)(((qrow0 >> 5) + qb) * 16 + h)) * 2048 + ((2 * d0 + hi) * 32 + q) * 8);
        f32x16 o[2][2];
#pragma unroll
        for (int qb = 0; qb < 2; ++qb)
#pragma unroll
            for (int db = 0; db < 2; ++db)
#pragma unroll
                for (int r = 0; r < 16; ++r) o[qb][db][r] = 0.f;
        float mrun[2] = {-1e30f, -1e30f}, lrun[2] = {0.f, 0.f};
        bf16x8 Kf[4], Vf[2][2];
        ATT_LOAD(tile_lo, Kf, Vf);
        for (int t = tile_lo; t < 18; ++t) {
            bf16x8 Kn[4], Vn[2][2];
            const int tn = (t + 1 < 18) ? t + 1 : t;
            ATT_LOAD(tn, Kn, Vn);
            f32x16 sc[2];
#pragma unroll
            for (int qb = 0; qb < 2; ++qb)
#pragma unroll
                for (int r = 0; r < 16; ++r) sc[qb][r] = 0.f;
#pragma unroll
            for (int d0 = 0; d0 < 4; ++d0)
#pragma unroll
                for (int qb = 0; qb < 2; ++qb) sc[qb] = __builtin_amdgcn_mfma_f32_32x32x16_bf16(Kf[d0], Qf[qb][d0], sc[qb], 0, 0, 0);
            if (t >= 12) {
#pragma unroll
                for (int qb = 0; qb < 2; ++qb)
#pragma unroll
                    for (int r = 0; r < 16; ++r) { const int dist = 512 + 32 * qb + q - (32 * t + crow(r, hi)); const int idx = (dist > 128 ? 128 : dist) + 128; sc[qb][r] += tab[h * 260 + idx]; }
            }
            float mx[2];
#pragma unroll
            for (int qb = 0; qb < 2; ++qb) { float a = fmaxf(fmaxf(sc[qb][0], sc[qb][1]), fmaxf(sc[qb][2], sc[qb][3]));
#pragma unroll
                for (int r = 4; r < 16; r += 4) a = fmaxf(a, fmaxf(fmaxf(sc[qb][r], sc[qb][r + 1]), fmaxf(sc[qb][r + 2], sc[qb][r + 3])));
                mx[qb] = fmaxf(a, __shfl_xor(a, 32)); }
            if (__any((mx[0] > mrun[0] + 8.0f) || (mx[1] > mrun[1] + 8.0f))) {
#pragma unroll
                for (int qb = 0; qb < 2; ++qb) { const float mnew = fmaxf(mrun[qb], mx[qb]), alpha = __builtin_amdgcn_exp2f(mrun[qb] - mnew); mrun[qb] = mnew; lrun[qb] *= alpha;
#pragma unroll
                    for (int db = 0; db < 2; ++db)
#pragma unroll
                        for (int r = 0; r < 16; ++r) o[qb][db][r] *= alpha; } }
            bf16x8 Pf[2][2];
#pragma unroll
            for (int qb = 0; qb < 2; ++qb) { const float mref = mrun[qb]; float ps0 = 0.f, ps1 = 0.f;
#pragma unroll
                for (int r = 0; r < 16; r += 2) { sc[qb][r] = __builtin_amdgcn_exp2f(sc[qb][r] - mref); sc[qb][r + 1] = __builtin_amdgcn_exp2f(sc[qb][r + 1] - mref); ps0 += sc[qb][r]; ps1 += sc[qb][r + 1]; }
                lrun[qb] += ps0 + ps1;
#pragma unroll
                for (int s = 0; s < 2; ++s) { typedef float f2_t __attribute__((ext_vector_type(2))); typedef __bf16 b2_t __attribute__((ext_vector_type(2))); u32x4 w;
#pragma unroll
                    for (int e = 0; e < 4; ++e) { const f2_t pr = {sc[qb][8 * s + 2 * e], sc[qb][8 * s + 2 * e + 1]}; w[e] = __builtin_bit_cast(unsigned, __builtin_convertvector(pr, b2_t)); }
                    Pf[qb][s] = __builtin_bit_cast(bf16x8, w); } }
#pragma unroll
            for (int s = 0; s < 2; ++s)
#pragma unroll
                for (int db = 0; db < 2; ++db)
#pragma unroll
                    for (int qb = 0; qb < 2; ++qb) o[qb][db] = __builtin_amdgcn_mfma_f32_32x32x16_bf16(Vf[db][s], Pf[qb][s], o[qb][db], 0, 0, 0);
#pragma unroll
            for (int d0 = 0; d0 < 4; ++d0) Kf[d0] = Kn[d0];
#pragma unroll
            for (int db = 0; db < 2; ++db)
#pragma unroll
                for (int s = 0; s < 2; ++s) Vf[db][s] = Vn[db][s];
        }
#undef ATT_LOAD
#pragma unroll
        for (int qb = 0; qb < 2; ++qb) { const float lt = lrun[qb] + __shfl_xor(lrun[qb], 32), inv = 1.0f / lt;
            bf16* orow = O + (size_t)(qrow0 + 32 * qb + q) * 1024 + h * 64;
#pragma unroll
            for (int db = 0; db < 2; ++db)
#pragma unroll
                for (int g = 0; g < 4; ++g) { u32x2 w; w.x = pk2(o[qb][db][4 * g] * inv, o[qb][db][4 * g + 1] * inv); w.y = pk2(o[qb][db][4 * g + 2] * inv, o[qb][db][4 * g + 3] * inv);
                    *(u32x2*)(orow + 32 * db + 8 * g + 4 * hi) = w; } }
      }
    }
}

template <int CTRL> __device__ __forceinline__ float dpp_mov(float v) { return __int_as_float(__builtin_amdgcn_update_dpp(0, __float_as_int(v), CTRL, 0xf, 0xf, false)); }
__device__ __forceinline__ float row16_sum(float v) { v += dpp_mov<0xB1>(v); v += dpp_mov<0x4E>(v); v += dpp_mov<0x124>(v); v += dpp_mov<0x128>(v); return v; }
__device__ __forceinline__ void conv_phase(LAS unsigned char* lds, const bf16* U, const float* state, const float* wdw, const float* bdw, const float* lng, const float* lnb, bf16* Z, int blk, int nblk, int tid) {
    LAS unsigned* tile = (LAS unsigned*)lds;
    typedef float f32x2 __attribute__((ext_vector_type(2)));
    LAS f32x2* stat = (LAS f32x2*)(lds + STAT_OFF);
    LAS f32x2* wpart = (LAS f32x2*)(lds + STAT_OFF + 256);
    const int c0 = 2 * tid, lane = tid & 63, wave = tid >> 6;
    f32x2 w[31];
#pragma unroll
    for (int k = 0; k < 31; ++k) w[k] = *(const f32x2*)(wdw + tid * 64 + 2 * k);
    const f32x2 bd = *(const f32x2*)(bdw + c0), gg = *(const f32x2*)(lng + c0), bb = *(const f32x2*)(lnb + c0);
    for (int unit = blk; unit < 1024 + 64; unit += nblk) {
        int t0, ng, p0; long base; const float* hist = nullptr;
        if (unit < 1024) { t0 = unit * 32; ng = 4; p0 = t0 & 16383; base = t0 - p0; } else { t0 = NP + (unit - 1024) * 8; ng = 1; const int s = (t0 - NP) >> 6; p0 = (t0 - NP) & 63; base = t0 - p0; hist = state + (size_t)s * 30 * 1024; }
        if (p0 >= 32) {
            const char* ub = (const char*)(U + (size_t)(base + p0 - 32) * 1024); const unsigned voff = (unsigned)(tid >> 7) * 2048u + (unsigned)(tid & 127) * 16u;
#pragma unroll
            for (int hb = 0; hb < 2; ++hb) { u32x4 tv[8];
#pragma unroll
                for (int k = 0; k < 8; ++k) tv[k] = *(const u32x4*)(ub + (size_t)(8 * hb + k) * 8192 + voff);
#pragma unroll
                for (int k = 0; k < 8; ++k) *(LAS u32x4*)(lds + (size_t)(8 * hb + k) * 8192 + voff) = tv[k]; }
        } else {
#pragma unroll
        for (int k = 0; k < 16; ++k) { const int idx = tid + 512 * k, j = idx >> 7, pc = idx & 127, pos = p0 - 32 + j; u32x4 v = (u32x4){0u, 0u, 0u, 0u};
            if (pos >= 0) v = *(const u32x4*)(U + (size_t)(base + pos) * 1024 + pc * 8);
            else if (hist && pos >= -30) { const f32x4 x0 = *(const f32x4*)(hist + (size_t)(30 + pos) * 1024 + pc * 8), x1 = *(const f32x4*)(hist + (size_t)(30 + pos) * 1024 + pc * 8 + 4); v = pg8::pack8(x0, x1); }
            *(LAS u32x4*)(lds + (size_t)j * 2048 + pc * 16) = v; }
        }
        __syncthreads();
#pragma unroll 1
        for (int g = 0; g < ng; ++g) {
            f32x2 y[8];
#pragma unroll
            for (int tt = 0; tt < 8; ++tt) y[tt] = bd;
#pragma unroll
            for (int jj = 0; jj < 38; ++jj) { const unsigned v = tile[(8 * g + 2 + jj) * 512 + tid]; const f32x2 rv = (f32x2){__uint_as_float(v << 16), __uint_as_float(v & 0xffff0000u)};
#pragma unroll
                for (int tt = 0; tt < 8; ++tt) { const int k = jj - tt; if (k >= 0 && k <= 30) y[tt] = rv * w[k] + y[tt]; }
                if ((jj & 3) == 3) __builtin_amdgcn_sched_barrier(0); }
#pragma unroll
            for (int tt = 0; tt < 8; ++tt) { const f32x2 sq = y[tt] * y[tt]; const float s1 = row16_sum(y[tt][0] + y[tt][1]), s2 = row16_sum(sq[0] + sq[1]);
                if ((lane & 15) == 0) wpart[(8 * g + tt) * 32 + wave * 4 + (lane >> 4)] = (f32x2){s1, s2};
                tile[(8 * g + tt) * 512 + tid] = pk2(y[tt][0], y[tt][1]); }
        }
        __syncthreads();
        { const int t = tid >> 4, sub = tid & 15; const f32x2 pa = wpart[t * 32 + sub], pb = wpart[t * 32 + sub + 16];
          const float s1 = row16_sum(pa[0] + pb[0]), s2 = row16_sum(pa[1] + pb[1]);
          if (sub == 0) { const float mean = s1 * (1.0f / 1024.0f), var = fmaxf(s2 * (1.0f / 1024.0f) - mean * mean, 0.f); stat[t] = (f32x2){mean, __builtin_amdgcn_rsqf(var + 1e-6f)}; } }
        __syncthreads();
#pragma unroll 8
        for (int t = 0; t < 8 * ng; ++t) { const f32x2 st = stat[t]; const unsigned v = tile[t * 512 + tid]; const float y0 = __uint_as_float(v << 16), y1 = __uint_as_float(v & 0xffff0000u);
            const float a0 = (y0 - st[0]) * st[1] * gg[0] + bb[0], a1 = (y1 - st[0]) * st[1] * gg[1] + bb[1];
            *(unsigned*)(Z + (size_t)(t0 + t) * 1024 + c0) = pk2(a0 * pg8::sigm(a0), a1 * pg8::sigm(a1)); }
        __syncthreads();
    }
}

__global__ void __launch_bounds__(512, 2) mk_fwd(Args args) {
    extern __shared__ __attribute__((aligned(16))) unsigned char lds_raw[];
    LAS unsigned char* lds = (LAS unsigned char*)lds_raw;
    cg::grid_group grid = cg::this_grid();
    const int G = gridDim.x, bx = blockIdx.x;
    const int ngw = G * 8;
    CArgs* kp0 = (CArgs*)__builtin_amdgcn_kernarg_segment_ptr();
    const int ph_lo = kp0->ph_lo, ph_hi = kp0->ph_hi;
    if (threadIdx.x < 16) ((volatile LAS unsigned*)(lds + MISC_OFF))[threadIdx.x] = 0u;
    __syncthreads();
    const XcdBarrier bar = xcd_barrier_post((unsigned*)(kp0->ws + WS_BAR), (volatile LAS unsigned*)(lds + MISC_OFF));
    const int tid0 = threadIdx.x;
#ifdef REP_MASK
    int rep = 0;
#endif
    unsigned* pend = nullptr;
    for (int ph = ph_lo; ph < ph_hi; ++ph) {
        CArgs* kp = kp0; asm volatile("" : "+s"(kp));
        unsigned char* ws = kp->ws; float* X = kp->out; float* ssb = (float*)(ws + WS_SS); unsigned* cntb = (unsigned*)(ws + WS_CNT);
        bf16* XB = (bf16*)(ws + WS_XB); bf16* H = (bf16*)(ws + WS_H); bf16* OB = (bf16*)(ws + WS_O);
        int tid = tid0; asm volatile("" : "+v"(tid));
        const int lane = tid & 63, wave = __builtin_amdgcn_readfirstlane(tid >> 6); const int gw = bx * 8 + wave;
        int depb = -1, mineb = -1, start = 0; unsigned need = 0;
        switch (ph) {
        case 1: mineb = 0; start = 0; break;            case 2: depb = 0; need = 176; start = 26; break;
        case 5: mineb = 1; start = 0; break;            case 6: depb = 1; need = 32; mineb = 2; start = 31; break;
        case 7: depb = 2; need = 176; mineb = 3; start = 25; break;   case 8: depb = 3; need = 32; mineb = 4; start = 24; break;
        case 9: depb = 4; need = 176; mineb = 5; start = 18; break;   case 10: depb = 5; need = 32; start = 17; break;
        case 12: mineb = 6; start = 0; break;           case 13: depb = 6; need = 32; mineb = 7; start = 31; break;
        case 14: depb = 7; need = 176; start = 25; break;
        default: break; }
#ifdef NOCHAIN
        depb = -1; mineb = -1; start = 0;
#endif
        pg8::ChainOrder S; S.dep = depb >= 0 ? cntb + depb * CNT_BANK : nullptr; S.need = need; S.mine = mineb >= 0 ? cntb + mineb * CNT_BANK : nullptr; S.pendp = &pend; S.lane = lane; S.okflag = (volatile LAS unsigned*)(lds + MISC_OFF + 16); S.rot = start; S.rl = (ph == 1) ? 6 : (ph == 6 || ph == 13) ? 7 : (ph == 8) ? 14 : -1; S.h0 = (ph == 8) ? 22 : 20;
        const int crot = bx;
        switch (ph) {
#ifndef PHMASK
#define PHMASK 0xFFFF
#endif
#define PHON(k) ((PHMASK >> (k)) & 1)
        case 0: if (PHON(0)) p0_prologue(kp, lds, gw, ngw, wave, lane); break;
        case 1: case 6: case 8: case 13: if (PHON(1)) {
            const int F = (ph == 1) ? 0 : (ph == 6) ? 1 : (ph == 8) ? 2 : 3, si = (ph == 1) ? 0 : (ph == 6) ? 2 : (ph == 8) ? 3 : 5;
            pg8::Gemm g{XB, (const bf16*)(ws + WS_WGU) + (size_t)F * 2 * FF * D, TT, 2 * FF, D}; S.init(TT, 2 * FF, G, crot);
            pg8::EpiGlu<0> E{H, FF, ssb + (size_t)si * TT, nullptr, 0, nullptr, nullptr, &pend, lane};
            pg8::gemm_phase<pg8::EpiGlu<0>, pg8::ChainOrder, true, true, false>(lds, g, S, E, tid); } break;
        case 2: case 7: case 9: case 14: case 5: case 12: if (PHON(2)) {
            const bf16* A; const bf16* B; int K; float alpha; const float* bias = nullptr; int so;
            if (ph == 5) { A = OB; B = (const bf16*)(ws + WS_WO); K = D; alpha = 1.0f; so = 2; }
            else if (ph == 12) { A = OB; B = (const bf16*)(ws + WS_WPW2); K = D; alpha = 1.0f; bias = kp->in[27]; so = 5; }
            else { const int F = (ph == 2) ? 0 : (ph == 7) ? 1 : (ph == 9) ? 2 : 3; A = H; B = (const bf16*)(ws + WS_WD) + (size_t)F * D * FF; K = FF; alpha = 0.5f; so = (ph == 2) ? 1 : (ph == 7) ? 3 : (ph == 9) ? 4 : -1; }
            pg8::Gemm g{A, B, TT, D, K}; S.init(TT, D, G, crot);
            pg8::EpiRes E{X, so >= 0 ? XB : nullptr, so >= 0 ? ssb + (size_t)so * TT : nullptr, bias, alpha, &pend, lane, (ph == 2) ? kp->in[0] : nullptr, (ph == 2) ? kp->in[1] : nullptr};
            pg8::gemm_phase<pg8::EpiRes, pg8::ChainOrder, true, true, false>(lds, g, S, E, tid); } break;
        case 3: if (PHON(3)) {
            { pg8::Gemm g{XB, (const bf16*)(ws + WS_WQK), TT, 2 * D, D}; pg8::StaticOrder S0; S0.init(TT, 2 * D, G, bx);
              pg8::EpiQK E{(bf16*)(ws + WS_Q), (bf16*)(ws + WS_K), ssb + (size_t)1 * TT, kp->in[15], kp->in[16], X + 34078720, X + 36175872};
              pg8::gemm_phase<pg8::EpiQK, pg8::StaticOrder, true, true>(lds, g, S0, E, tid); }
            { pg8::Gemm g{(const bf16*)(ws + WS_WV), XB, D, TT, D}; pg8::StaticOrder S0; S0.init(D, TT, G, (G == 256) ? ((bx + 128) & 255) : bx);
              pg8::EpiVT E{(bf16*)(ws + WS_VT), ssb + (size_t)1 * TT, X + 35127296, X + 36700160};
              pg8::gemm_phase<pg8::EpiVT, pg8::StaticOrder, true, true>(lds, g, S0, E, tid); } } break;
        case 4: if (PHON(4)) attn_phase(lds, (const bf16*)(ws + WS_Q), (const bf16*)(ws + WS_K), (const bf16*)(ws + WS_VT), (const bf16*)(ws + WS_KC), (const bf16*)(ws + WS_VCT), OB, kp->in[17], gw, ngw, tid); break;
        case 10: if (PHON(10)) {
            pg8::Gemm g{XB, (const bf16*)(ws + WS_WPW1), TT, 2 * D, D}; S.init(TT, 2 * D, G, crot);
            pg8::EpiGlu<1> E{(bf16*)(ws + WS_U), D, ssb + (size_t)4 * TT, kp->in[21], D, X + 37224448, X + 37285888, &pend, lane};
            pg8::gemm_phase<pg8::EpiGlu<1>, pg8::ChainOrder, true, true, false>(lds, g, S, E, tid); } break;
        case 11: if (PHON(11)) conv_phase(lds, (const bf16*)(ws + WS_U), kp->in[4], (const float*)(ws + WS_WDWT), kp->in[23], kp->in[24], kp->in[25], OB, bx, G, tid); break;
        default: break;
        }
#ifdef NOCHAIN
        const bool chain_inner = false;
#else
        const bool chain_inner = (ph == 1) || (ph >= 5 && ph <= 9) || ph == 12 || ph == 13;
#endif
        if (!chain_inner || ph + 1 >= ph_hi) { if (pend) { asm volatile("s_waitcnt vmcnt(0)" ::: "memory"); if (lane == 0) __hip_atomic_fetch_add(pend, 1u, __ATOMIC_RELAXED, __HIP_MEMORY_SCOPE_AGENT); pend = nullptr; } }
        if (ph + 1 < ph_hi && !chain_inner) { if (ph_hi > 1000) grid.sync();   xcd_barrier(bar); }
    }
}

#ifndef MK_N_LAUNCHES
#define MK_N_LAUNCHES 1
#endif
extern "C" void kernel_launch(void* const* d_in, const int* in_sizes, int n_in, void* d_out, int out_size, void* d_ws, size_t ws_size, hipStream_t stream) {
    static int grid = 0;
    if (grid == 0) {
        if (n_in != 28 || out_size != 37531648 || ws_size < WS_END) { fprintf(stderr, "kernel_launch: unexpected problem: n_in %d out %d ws %zu\n", n_in, out_size, ws_size); grid = -1; return; }
        int dev = 0, cus = 0, per_cu = 0;
        (void)hipGetDevice(&dev); (void)hipDeviceGetAttribute(&cus, hipDeviceAttributeMultiprocessorCount, dev);
        if (hipFuncSetAttribute((const void*)mk_fwd, hipFuncAttributeMaxDynamicSharedMemorySize, LDS_BYTES) != hipSuccess) { fprintf(stderr, "kernel_launch: hipFuncSetAttribute failed\n"); grid = -1; return; }
        if (hipOccupancyMaxActiveBlocksPerMultiprocessor(&per_cu, (const void*)mk_fwd, 512, LDS_BYTES) != hipSuccess || per_cu < 1) { fprintf(stderr, "kernel_launch: occupancy query gave %d\n", per_cu); per_cu = 1; }
        (void)hipGetLastError();
        grid = cus * per_cu; if (grid <= 0) grid = 256;
    }
    if (grid < 0) return;
    (void)hipMemsetAsync((char*)d_ws + WS_SS, 0, 1 * MiB, stream);
    Args a{};
    for (int i = 0; i < 28; ++i) a.in[i] = (const float*)d_in[i];
    a.out = (float*)d_out; a.ws = (unsigned char*)d_ws;
    constexpr int NPH = 15;
    if (MK_N_LAUNCHES == 1) {
        a.ph_lo = 0; a.ph_hi = NPH; void* kargs[] = {&a};
        hipError_t e = hipLaunchCooperativeKernel((const void*)mk_fwd, dim3(grid), dim3(512), kargs, LDS_BYTES, stream);
        if (e != hipSuccess) fprintf(stderr, "kernel_launch: cooperative launch failed: %s (grid %d)\n", hipGetErrorString(e), grid);
    } else {
        for (int p = 0; p < NPH; ++p) { a.ph_lo = p; a.ph_hi = p + 1; hipLaunchKernelGGL(mk_fwd, dim3(grid), dim3(512), LDS_BYTES, stream, a); }
    }
}
```

```cpp
#include <hip/hip_runtime.h>
#include <hip/hip_cooperative_groups.h>
#include <cstdio>
#include <cstdint>
namespace cg = cooperative_groups;
namespace pg8 {
#define PG8_LAS __attribute__((address_space(3)))
typedef unsigned short bf16_t;
typedef short bf16x8 __attribute__((ext_vector_type(8)));
typedef float f32x4 __attribute__((ext_vector_type(4)));
typedef unsigned u32x4 __attribute__((ext_vector_type(4)));
constexpr int BM = 256, BK = 64, HALF = 128, HTB = HALF * BK * 2  , STAGE_BYTES = 8 * HTB, NXCD = 8, WGM = 8;

__host__ __device__ __forceinline__ int lds_byte(int r, int c) { const int st = (r >> 4) * 2 + (c >> 5), rr = r & 15, cc = c & 31, ob = rr * 64 + cc * 2; return st * 1024 + (ob ^ (((ob >> 9) & 1) << 5)); }
__host__ __device__ __forceinline__ void stage_rc(int b, int& R, int& C) { const int st = b / 1024, sb = b % 1024, swz = sb ^ (((sb >> 9) & 1) << 5); R = (st >> 1) * 16 + swz / 64; C = (st & 1) * 32 + (swz % 64) / 2; }
__host__ __device__ __forceinline__ int perm32(int rho) { const int n = rho >> 4, i = rho & 15; return 8 * (i >> 2) + 4 * n + (i & 3); }

struct Unit { int pm, pn; };
struct Gemm { const bf16_t* A; const bf16_t* Bt; int M, N, K; };

struct StaticOrder {
    int nM, nN, nwg, G, c;
    __host__ __device__ void init(int M, int N, int G_, int c_) { nM = M / BM; nN = N / BM; nwg = nM * nN; G = G_; c = c_; }
    __host__ __device__ bool next(int i, Unit& u) const {
        const long L = (long)i * G + c; if (L >= nwg) return false;
        int wgid = (int)L; { const int q = nwg / NXCD, r = nwg % NXCD, xcd = wgid % NXCD, off = wgid / NXCD; wgid = (xcd < r ? xcd * (q + 1) : r * (q + 1) + (xcd - r) * q) + off; }
        const int nig = WGM * nN, gid = wgid / nig, fm = gid * WGM, gsz = (nM - fm) < WGM ? (nM - fm) : WGM;
        u.pm = fm + ((wgid % nig) % gsz); u.pn = (wgid % nig) / gsz; return true;
    }
    __device__ __forceinline__ void a_ready(const Unit&) const {}
    __device__ __forceinline__ void done(const Unit&, bool) const {}
    __device__ __forceinline__ unsigned poll_issue(const Unit&) const { return 0u; }
    __device__ __forceinline__ void poll_check(unsigned) const {}
    __device__ __forceinline__ void a_ready_next(const Unit&) const {}
};
struct ChainOrder : StaticOrder {
    const unsigned* dep; unsigned need; unsigned* mine; unsigned** pendp; int lane; volatile PG8_LAS unsigned* okflag;
    int rot, rl, h0;
    __device__ __forceinline__ bool next(int i, Unit& u) const {
        if (G != 256 || nM != 130) return StaticOrder::next(i, u);
        const int x = c & 7, l = c >> 3, j = (l + rot) & 31, nmain = 16 * nN; int w = i * 32 + j;
        if (rl >= 0) {
            if (l == rl && i >= 9) return false;
            if ((l == h0 || l == h0 + 1) && i == 11) w = (9 + (l - h0)) * 32 + ((rl + rot) & 31); }
        if (w < nmain) { const int nig = 8 * nN, gid = w / nig; u.pm = 16 * x + 8 * gid + ((w % nig) & 7); u.pn = (w % nig) >> 3; return true; }
        const int sidx = x + 8 * (w - nmain); if (sidx >= 2 * nN) return false;
        u.pm = 128 + (sidx & 1); u.pn = sidx >> 1; return true;
    }
    __device__ __forceinline__ void publish(unsigned* p) const { if (lane == 0) __hip_atomic_fetch_add(p, 1u, __ATOMIC_RELAXED, __HIP_MEMORY_SCOPE_AGENT); }
    __device__ __forceinline__ void flush() const { if (*pendp) { asm volatile("s_waitcnt vmcnt(0)" ::: "memory"); publish(*pendp); *pendp = nullptr; } }
    __device__ __forceinline__ void wait_panel(const Unit& u) const {
        const unsigned* w = dep + 16 * u.pm; unsigned spins = 0;
        while ((unsigned)__builtin_amdgcn_readfirstlane(__hip_atomic_load(w, __ATOMIC_RELAXED, __HIP_MEMORY_SCOPE_AGENT)) < need) { __builtin_amdgcn_s_sleep(2); if (++spins > (1u << 20)) break; }
        __builtin_amdgcn_fence(__ATOMIC_ACQUIRE, "agent"); asm volatile("s_waitcnt vmcnt(0)" ::: "memory");
    }
    __device__ __forceinline__ void a_ready(const Unit& u) const {
        flush();
        if (dep) { if (threadIdx.x < 64) wait_panel(u); asm volatile("" ::: "memory"); __builtin_amdgcn_s_barrier(); asm volatile("" ::: "memory"); }
    }
    __device__ __forceinline__ unsigned poll_issue(const Unit& u) const { return (dep && threadIdx.x < 64) ? __hip_atomic_load(dep + 16 * u.pm, __ATOMIC_RELAXED, __HIP_MEMORY_SCOPE_AGENT) : 0u; }
    __device__ __forceinline__ void poll_check(unsigned v) const {
        if (dep && threadIdx.x < 64) { const bool ok = (unsigned)__builtin_amdgcn_readfirstlane(v) >= need; if (ok) asm volatile("buffer_inv sc1" ::: "memory"); if (lane == 0) okflag[0] = ok ? 1u : 0u; }
    }
    __device__ __forceinline__ void a_ready_next(const Unit& u) const {
        if (dep) {
            const bool ok = okflag[0] != 0u;
            if (!ok) { flush(); if (threadIdx.x < 64) wait_panel(u); }
            asm volatile("" ::: "memory"); __builtin_amdgcn_s_barrier(); asm volatile("" ::: "memory");
        }
    }
    __device__ __forceinline__ void done(const Unit& u, bool has_next) const {
        unsigned* m = mine ? mine + 16 * u.pm : nullptr;
        if (has_next) { flush(); *pendp = m; }
        else { asm volatile("s_waitcnt vmcnt(0)" ::: "memory"); if (*pendp) { publish(*pendp); *pendp = nullptr; } if (m) publish(m); }
    }
};
__device__ __forceinline__ void publish_prev(unsigned** pendp, int lane, float witness) {
    asm volatile("" :: "v"(witness) : "memory");
    if (*pendp) { if (lane == 0) __hip_atomic_fetch_add(*pendp, 1u, __ATOMIC_RELAXED, __HIP_MEMORY_SCOPE_AGENT); *pendp = nullptr; }
}
__device__ __forceinline__ unsigned cvt_pk_bf16(float lo, float hi) { unsigned r; asm volatile("v_cvt_pk_bf16_f32 %0, %1, %2" : "=v"(r) : "v"(lo), "v"(hi)); return r; }
typedef float f32x2 __attribute__((ext_vector_type(2)));
constexpr int TT = 33280, NP = 32768;
constexpr float RMS_EPS = 1e-6f, LOG2E = 1.4426950408889634f;
__device__ __forceinline__ float sigm(float x) { return __builtin_amdgcn_rcpf(1.0f + __builtin_amdgcn_exp2f(-LOG2E * x)); }
__device__ __forceinline__ float rs_from_ss(float ss) { return __builtin_amdgcn_rsqf(ss * (1.0f / 1024.0f) + RMS_EPS); }
__device__ __forceinline__ void st16_wt(void* p, u32x4 v) { asm volatile("global_store_dwordx4 %0, %1, off sc1\n\ts_nop 1" :: "v"(p), "v"(v) : "memory"); }
__device__ __forceinline__ void st16f_wt(void* p, f32x4 v) { asm volatile("global_store_dwordx4 %0, %1, off sc1\n\ts_nop 1" :: "v"(p), "v"(v) : "memory"); }
typedef unsigned u32x2w __attribute__((ext_vector_type(2)));
__device__ __forceinline__ void st8_wt(void* p, u32x2w v) { asm volatile("global_store_dwordx2 %0, %1, off sc1\n\ts_nop 1" :: "v"(p), "v"(v) : "memory"); }
__device__ __forceinline__ float ld_f32_ag(const float* p) { return *p; }
__device__ __forceinline__ f32x4 ld16f_ag(const float* p) { return *(const f32x4*)p; }
__device__ __forceinline__ u32x4 pack8(const f32x4& a, const f32x4& b) { u32x4 w; w.x = cvt_pk_bf16(a[0], a[1]); w.y = cvt_pk_bf16(a[2], a[3]); w.z = cvt_pk_bf16(b[0], b[1]); w.w = cvt_pk_bf16(b[2], b[3]); return w; }

template <int MODE> struct EpiGlu {
    static constexpr bool PERM = true, AFTER_DRAIN = false;
    bf16_t* O; int ldc; const float* ss; const float* bias; int nh; float* cp; float* cs; unsigned** pendp; int lane;
    __device__ __forceinline__ void operator()(const f32x4 (&acc)[2][2][4][2], const Unit& u, int wr, int wc, int fr, int fq) const {
        const int row0 = u.pm * BM + wr * 64 + fr, col0 = u.pn * 128 + wc * 32 + 8 * fq;
        f32x4 b0[2], b1[2];
#pragma unroll
        for (int n = 0; n < 2; ++n) { b0[n] = (MODE == 1) ? *(const f32x4*)(bias + col0 + 4 * n) : (f32x4){0.f, 0.f, 0.f, 0.f}; b1[n] = (MODE == 1) ? *(const f32x4*)(bias + nh + col0 + 4 * n) : (f32x4){0.f, 0.f, 0.f, 0.f}; }
        float rsv[2][4];
#pragma unroll
        for (int ai = 0; ai < 2; ++ai)
#pragma unroll
            for (int m = 0; m < 4; ++m) rsv[ai][m] = ld_f32_ag(ss + row0 + ai * HALF + m * 16);
        publish_prev(pendp, lane, rsv[1][3]);
#pragma unroll
        for (int ai = 0; ai < 2; ++ai)
#pragma unroll
            for (int m = 0; m < 4; ++m) { const int row = row0 + ai * HALF + m * 16; const float rs = rs_from_ss(rsv[ai][m]); f32x4 o[2];
#pragma unroll
                for (int n = 0; n < 2; ++n) { const f32x4 v0 = acc[ai][0][m][n] * rs + b0[n], v1 = acc[ai][1][m][n] * rs + b1[n];
                    const f32x4 sx = (MODE == 0) ? v0 : v1, tt = sx * (-LOG2E); f32x4 dd;
#pragma unroll
                    for (int i = 0; i < 4; ++i) dd[i] = __builtin_amdgcn_exp2f(tt[i]);
                    dd = dd + 1.0f;
#pragma unroll
                    for (int i = 0; i < 4; ++i) dd[i] = __builtin_amdgcn_rcpf(dd[i]);
                    o[n] = (MODE == 0) ? (v0 * dd) * v1 : v0 * dd; }
                st16_wt(O + (size_t)row * ldc + col0, pack8(o[0], o[1]));
                if (MODE == 1) { float* dst = nullptr;
                    if (row < NP) { const int pos = row & 16383, b = row >> 14; if (pos >= 16354) dst = cp + ((size_t)(b * 30 + pos - 16354)) * 1024 + col0; }
                    else { const int i = (row - NP) & 63, s = (row - NP) >> 6; if (i >= 34) dst = cs + ((size_t)(s * 30 + i - 34)) * 1024 + col0; }
                    if (dst) { *(f32x4*)dst = o[0]; *(f32x4*)(dst + 4) = o[1]; } }
            }
    }
};
struct EpiRes {
    static constexpr bool PERM = false, AFTER_DRAIN = false;
    float* X; bf16_t* XB; float* ssout; const float* bias; float alpha; unsigned** pendp; int lane; const float* Xin0; const float* Xin1;
    __device__ __forceinline__ void operator()(const f32x4 (&acc)[2][2][4][2], const Unit& u, int wr, int wc, int fr, int fq) const {
        typedef unsigned u32x2v __attribute__((ext_vector_type(2)));
        const int row0 = u.pm * BM + wr * 64 + fr, col0 = u.pn * BM + wc * 32 + 4 * fq;
        f32x4 bv[2][2];
#pragma unroll
        for (int bj = 0; bj < 2; ++bj)
#pragma unroll
            for (int n = 0; n < 2; ++n) bv[bj][n] = bias ? *(const f32x4*)(bias + col0 + bj * HALF + n * 16) : (f32x4){0.f, 0.f, 0.f, 0.f};
        f32x4 xr[3][2][2];
#pragma unroll
        for (int gi = 0; gi < 2; ++gi)
#pragma unroll
            for (int bj = 0; bj < 2; ++bj)
#pragma unroll
                for (int n = 0; n < 2; ++n) { const int rr = row0 + (gi >> 2) * HALF + (gi & 3) * 16; const float* rb = Xin0 ? (rr < NP ? Xin0 + (size_t)rr * 1024 : Xin1 + (size_t)(rr - NP) * 1024) : X + (size_t)rr * 1024; xr[gi][bj][n] = ld16f_ag(rb + col0 + bj * HALF + n * 16); }
#pragma unroll
        for (int gi = 0; gi < 8; ++gi) { const int ai = gi >> 2, m = gi & 3; const int row = row0 + ai * HALF + m * 16; const size_t off = (size_t)row * 1024 + col0; float s = 0.f;
            if (gi < 6) { const int ai2 = (gi + 2) >> 2, m2 = (gi + 2) & 3; const int rr = row0 + ai2 * HALF + m2 * 16; const float* rb = Xin0 ? (rr < NP ? Xin0 + (size_t)rr * 1024 : Xin1 + (size_t)(rr - NP) * 1024) : X + (size_t)rr * 1024;
#pragma unroll
                for (int bj = 0; bj < 2; ++bj)
#pragma unroll
                    for (int n = 0; n < 2; ++n) xr[(gi + 2) % 3][bj][n] = ld16f_ag(rb + col0 + bj * HALF + n * 16); }
            f32x4 xc[2][2];
#pragma unroll
            for (int bj = 0; bj < 2; ++bj)
#pragma unroll
                for (int n = 0; n < 2; ++n) xc[bj][n] = xr[gi % 3][bj][n];
            if (gi == 0) publish_prev(pendp, lane, xc[1][1][3]);
#pragma unroll
            for (int bj = 0; bj < 2; ++bj)
#pragma unroll
                for (int n = 0; n < 2; ++n) { f32x4 x = xc[bj][n] + (acc[ai][bj][m][n] + bv[bj][n]) * alpha; st16f_wt(X + off + bj * HALF + n * 16, x);
                    if (XB) { u32x2w w; w.x = cvt_pk_bf16(x[0], x[1]); w.y = cvt_pk_bf16(x[2], x[3]); st8_wt(XB + off + bj * HALF + n * 16, w); }
                    s += (x[0] * x[0] + x[1] * x[1]) + (x[2] * x[2] + x[3] * x[3]); }
            if (ssout) { s += __shfl_xor(s, 16); s += __shfl_xor(s, 32); if (fq == 0) unsafeAtomicAdd(ssout + row, s); } }
    }
};
struct EpiQK {
    static constexpr bool PERM = true, AFTER_DRAIN = false;
    bf16_t* Q; bf16_t* Kb; const float* ss; const float* qg; const float* kg; float* kp; float* ks;
    __device__ __forceinline__ void operator()(const f32x4 (&acc)[2][2][4][2], const Unit& u, int wr, int wc, int fr, int fq) const {
        const int row0 = u.pm * BM + wr * 64 + fr; const bool isK = u.pn >= 4; const int head = 4 * (u.pn & 3) + wc;
        const float gs = isK ? 1.0f : 0.125f * LOG2E; const float* gp = isK ? kg : qg; bf16_t* dstb = isK ? Kb : Q;
        f32x4 g[2][2];
#pragma unroll
        for (int bj = 0; bj < 2; ++bj)
#pragma unroll
            for (int n = 0; n < 2; ++n) g[bj][n] = *(const f32x4*)(gp + 32 * bj + 8 * fq + 4 * n) * gs;
#pragma unroll
        for (int ai = 0; ai < 2; ++ai)
#pragma unroll
            for (int m = 0; m < 4; ++m) { const int row = row0 + ai * HALF + m * 16; const float rs = rs_from_ss(ss[row]); f32x4 v[2][2]; float sq = 0.f;
#pragma unroll
                for (int bj = 0; bj < 2; ++bj)
#pragma unroll
                    for (int n = 0; n < 2; ++n) { v[bj][n] = acc[ai][bj][m][n] * rs; sq += (v[bj][n][0] * v[bj][n][0] + v[bj][n][1] * v[bj][n][1]) + (v[bj][n][2] * v[bj][n][2] + v[bj][n][3] * v[bj][n][3]); }
                sq += __shfl_xor(sq, 16); sq += __shfl_xor(sq, 32);
                const float rn = __builtin_amdgcn_rsqf(sq * (1.0f / 64.0f) + RMS_EPS);
                float* kd = nullptr;
                if (isK) { if (row < NP) { const int pos = row & 16383, b = row >> 14; if (pos >= 15872) kd = kp + ((size_t)(b * 512 + pos - 15872)) * 1024 + head * 64 + 8 * fq; }
                           else kd = ks + (size_t)(row - NP) * 1024 + head * 64 + 8 * fq; }
#pragma unroll
                for (int bj = 0; bj < 2; ++bj) { const f32x4 o0 = v[bj][0] * rn * g[bj][0], o1 = v[bj][1] * rn * g[bj][1];
                    *(u32x4*)(dstb + ((size_t)((row >> 5) * 16 + head)) * 2048 + ((4 * bj + fq) * 32 + (row & 31)) * 8) = pack8(o0, o1);
                    if (kd) { *(f32x4*)(kd + 32 * bj) = o0; *(f32x4*)(kd + 32 * bj + 4) = o1; } }
            }
    }
};
struct EpiVT {
    static constexpr bool PERM = true, AFTER_DRAIN = false;
    bf16_t* VT; const float* ss; float* vp; float* vs;
    __device__ __forceinline__ void operator()(const f32x4 (&acc)[2][2][4][2], const Unit& u, int wr, int wc, int fr, int fq) const {
        const int f0 = u.pm * BM + wr * 64 + fr;
        f32x4 rs[2][2];
#pragma unroll
        for (int bj = 0; bj < 2; ++bj)
#pragma unroll
            for (int n = 0; n < 2; ++n) { const f32x4 s4 = *(const f32x4*)(ss + u.pn * BM + bj * HALF + wc * 32 + 8 * fq + 4 * n);
#pragma unroll
                for (int i = 0; i < 4; ++i) rs[bj][n][i] = rs_from_ss(s4[i]); }
#pragma unroll
        for (int ai = 0; ai < 2; ++ai)
#pragma unroll
            for (int m = 0; m < 4; ++m) { const int f = f0 + ai * HALF + m * 16;
#pragma unroll
                for (int bj = 0; bj < 2; ++bj) { const int tokb = u.pn * BM + bj * HALF + wc * 32, tok0 = tokb + 8 * fq;
                    const f32x4 o0 = acc[ai][bj][m][0] * rs[bj][0], o1 = acc[ai][bj][m][1] * rs[bj][1];
                    { typedef unsigned u32x2v __attribute__((ext_vector_type(2))); const int hh = f >> 6, db = (f >> 5) & 1, dd = f & 31, sl = fq >> 1, half = fq & 1;
                      bf16_t* vb = VT + ((size_t)((tokb >> 5) * 16 + hh)) * 2048 + (((db * 2 + sl) * 2) * 32 + dd) * 8 + 4 * half;
                      u32x2v w0, w1; w0.x = cvt_pk_bf16(o0[0], o0[1]); w0.y = cvt_pk_bf16(o0[2], o0[3]); w1.x = cvt_pk_bf16(o1[0], o1[1]); w1.y = cvt_pk_bf16(o1[2], o1[3]);
                      *(u32x2v*)vb = w0; *(u32x2v*)(vb + 256) = w1; }
                    const bool kept = (tokb < NP) ? ((tokb & 16383) >= 15872) : true;
                    if (kept) { float* d = (tok0 < NP) ? vp + ((size_t)((tok0 >> 14) * 512 + (tok0 & 16383) - 15872)) * 1024 + f : vs + (size_t)(tok0 - NP) * 1024 + f;
#pragma unroll
                        for (int i = 0; i < 4; ++i) { d[(size_t)i * 1024] = o0[i]; d[(size_t)(4 + i) * 1024] = o1[i]; } } }
            }
    }
};
template <class Epi, class Sched, bool ALIGN_EPI = false, bool SP2 = false, bool A_SC1 = false>
__device__ __forceinline__ void gemm_phase(PG8_LAS unsigned char* lds, const Gemm g, const Sched& S, const Epi& E, const int tid) {
    const int wid = __builtin_amdgcn_readfirstlane(tid >> 6), lane = tid & 63, wr = wid >> 2, wc = wid & 3, fr = lane & 15, fq = lane >> 4;
    const int K = g.K, nt = K / BK;
    unsigned voffA[2], voffB[2];
#pragma unroll
    for (int i = 0; i < 2; ++i) { int R, C; stage_rc(tid * 16 + i * 8192, R, C); const int Rb = Epi::PERM ? ((R & ~31) + perm32(R & 31)) : R;
        voffA[i] = (unsigned)(R * K + C) * 2u; voffB[i] = (unsigned)(Rb * K + C) * 2u; }
    const size_t kstep = (size_t)(BK * 2);
    const size_t hstep = (size_t)HALF * K * 2;
    const size_t tstep = 2 * hstep;
    const unsigned ldsw = (unsigned)wid * 1024u;
    const int aoff = lds_byte(wr * 64 + fr, fq * 8), boff = lds_byte(wc * 32 + fr, fq * 8);
#define PG8_SA(b, h) (((b) * 2 + (h)) * HTB)
#define PG8_SB(b, h) ((4 + (b) * 2 + (h)) * HTB)
#define PG8_STAGE(bufoff, gbase, voff) do { _Pragma("unroll") for (int _i = 0; _i < 2; ++_i) \
        __builtin_amdgcn_global_load_lds((const unsigned*)((const char*)(gbase) + (voff)[_i]), (PG8_LAS unsigned*)(lds + (bufoff) + ldsw + _i * 8192), 16, 0, 0); } while (0)
#define PG8_STAGEA(bufoff, gbase, voff) do { _Pragma("unroll") for (int _i = 0; _i < 2; ++_i) \
        __builtin_amdgcn_global_load_lds((const unsigned*)((const char*)(gbase) + (voff)[_i]), (PG8_LAS unsigned*)(lds + (bufoff) + ldsw + _i * 8192), 16, 0, A_SC1 ? 16 : 0); } while (0)
#define PG8_LDA(dst, b, h) do { _Pragma("unroll") for (int m = 0; m < 4; ++m) _Pragma("unroll") for (int k = 0; k < 2; ++k) dst[m][k] = *(const PG8_LAS bf16x8*)(lds + PG8_SA(b, h) + aoff + m * 2048 + k * 1024); } while (0)
#define PG8_LDB(dst, b, h) do { _Pragma("unroll") for (int n = 0; n < 2; ++n) _Pragma("unroll") for (int k = 0; k < 2; ++k) dst[n][k] = *(const PG8_LAS bf16x8*)(lds + PG8_SB(b, h) + boff + n * 2048 + k * 1024); } while (0)
#define PG8_MMA(ai, bj, At, Bt) do { __builtin_amdgcn_s_setprio(1); _Pragma("unroll") for (int m = 0; m < 4; ++m) _Pragma("unroll") for (int n = 0; n < 2; ++n) _Pragma("unroll") for (int k = 0; k < 2; ++k) \
        acc[ai][bj][m][n] = __builtin_amdgcn_mfma_f32_16x16x32_bf16(Bt[n][k], At[m][k], acc[ai][bj][m][n], 0, 0, 0); __builtin_amdgcn_s_setprio(0); } while (0)
#define PG8_WAIT_V(n) asm volatile("s_waitcnt vmcnt(" #n ")" ::: "memory")
#define PG8_WAIT_L(n) asm volatile("s_waitcnt lgkmcnt(" #n ")" ::: "memory")
#define PG8_BAR __builtin_amdgcn_s_barrier()
#define PG8_SCHED __builtin_amdgcn_sched_barrier(0)
    Unit cur, nxt; int ui = 0;
    if (!S.next(0, cur)) return;
    f32x4 acc[2][2][4][2];
#pragma unroll
    for (int a = 0; a < 2; ++a)
#pragma unroll
        for (int b = 0; b < 2; ++b)
#pragma unroll
            for (int m = 0; m < 4; ++m)
#pragma unroll
                for (int n = 0; n < 2; ++n) acc[a][b][m][n] = (f32x4){0.f, 0.f, 0.f, 0.f};
    bf16x8 At[4][2], B0[2][2], B1[2][2];
    const char* cA = (const char*)g.A + (size_t)cur.pm * tstep; const char* cB = (const char*)g.Bt + (size_t)cur.pn * tstep;
    S.a_ready(cur);
    if constexpr (SP2) {
        PG8_STAGE(PG8_SB(0, 0), cB, voffB); PG8_STAGE(PG8_SB(0, 1), cB + hstep, voffB); PG8_STAGEA(PG8_SA(0, 0), cA, voffA); PG8_STAGEA(PG8_SA(0, 1), cA + hstep, voffA);
        if (wr == 1) PG8_BAR;
        PG8_WAIT_V(2); PG8_BAR;
        PG8_STAGE(PG8_SB(1, 0), cB + kstep, voffB); PG8_STAGEA(PG8_SA(1, 0), cA + kstep, voffA); PG8_STAGE(PG8_SB(1, 1), cB + hstep + kstep, voffB);
        PG8_WAIT_V(6); PG8_BAR;
    } else {
        PG8_STAGE(PG8_SB(0, 0), cB, voffB); PG8_STAGEA(PG8_SA(0, 0), cA, voffA); PG8_STAGE(PG8_SB(0, 1), cB + hstep, voffB); PG8_STAGEA(PG8_SA(0, 1), cA + hstep, voffA);
        if (wr == 1) PG8_BAR;
        PG8_WAIT_V(4); PG8_BAR;
        PG8_STAGE(PG8_SB(1, 0), cB + kstep, voffB); PG8_STAGEA(PG8_SA(1, 0), cA + kstep, voffA); PG8_STAGE(PG8_SB(1, 1), cB + hstep + kstep, voffB);
        PG8_WAIT_V(6); PG8_BAR;
    }
    for (;;) {
        const bool has_next = S.next(ui + 1, nxt);
        const char* nA = has_next ? (const char*)g.A + (size_t)nxt.pm * tstep : cA; const char* nB = has_next ? (const char*)g.Bt + (size_t)nxt.pn * tstep : cB;
        unsigned pollv = 0u;
        for (int t = 0; t < nt; t += 2) {
            const bool last = (t == nt - 2);
            const char* a1 = cA + (size_t)(t + 1) * kstep;
            const char* a2 = last ? nA : cA + (size_t)(t + 2) * kstep; const char* b2 = last ? nB : cB + (size_t)(t + 2) * kstep;
            const char* a3 = a2 + kstep; const char* b3 = b2 + kstep;
            if (has_next) { if (t == nt - 6) pollv = S.poll_issue(nxt); else if (t == nt - 4) S.poll_check(pollv); }
            if (last && has_next) S.a_ready_next(nxt);
            if constexpr (SP2) {
            PG8_LDB(B0, 0, 0); PG8_LDB(B1, 0, 1); PG8_SCHED; PG8_LDA(At, 0, 0); PG8_STAGEA(PG8_SA(1, 1), a1 + hstep, voffA);
            PG8_WAIT_V(8); PG8_WAIT_L(0); PG8_BAR; PG8_MMA(0, 0, At, B0); PG8_MMA(0, 1, At, B1); PG8_BAR; PG8_SCHED;
            PG8_LDA(At, 0, 1); PG8_STAGE(PG8_SB(0, 0), b2, voffB); PG8_STAGE(PG8_SB(0, 1), b2 + hstep, voffB); PG8_STAGEA(PG8_SA(0, 0), a2, voffA);
            PG8_WAIT_V(8); PG8_WAIT_L(0); PG8_BAR; PG8_MMA(1, 0, At, B0); PG8_MMA(1, 1, At, B1); PG8_BAR; PG8_SCHED;
            PG8_LDB(B0, 1, 0); PG8_LDB(B1, 1, 1); PG8_SCHED; PG8_LDA(At, 1, 0); PG8_STAGEA(PG8_SA(0, 1), a2 + hstep, voffA);
            PG8_WAIT_V(8); PG8_WAIT_L(0); PG8_BAR; PG8_MMA(0, 0, At, B0); PG8_MMA(0, 1, At, B1); PG8_BAR; PG8_SCHED;
            PG8_LDA(At, 1, 1); PG8_STAGE(PG8_SB(1, 0), b3, voffB); PG8_STAGE(PG8_SB(1, 1), b3 + hstep, voffB); PG8_STAGEA(PG8_SA(1, 0), a3, voffA);
            PG8_WAIT_V(8); PG8_WAIT_L(0); PG8_BAR; PG8_MMA(1, 0, At, B0); PG8_MMA(1, 1, At, B1); PG8_BAR; PG8_SCHED;
            } else {
            PG8_LDB(B0, 0, 0); PG8_SCHED; PG8_LDA(At, 0, 0); PG8_STAGEA(PG8_SA(1, 1), a1 + hstep, voffA);
            PG8_WAIT_L(8); PG8_BAR; PG8_WAIT_L(0); PG8_MMA(0, 0, At, B0); PG8_BAR; PG8_SCHED;
            PG8_LDB(B1, 0, 1); PG8_STAGE(PG8_SB(0, 0), b2, voffB);
            PG8_BAR; PG8_WAIT_L(0); PG8_MMA(0, 1, At, B1); PG8_BAR;
            PG8_LDA(At, 0, 1); PG8_STAGEA(PG8_SA(0, 0), a2, voffA);
            PG8_BAR; PG8_WAIT_L(0); PG8_MMA(1, 0, At, B0); PG8_BAR; PG8_SCHED;
            PG8_STAGE(PG8_SB(0, 1), b2 + hstep, voffB);
            PG8_WAIT_V(6); PG8_BAR; PG8_MMA(1, 1, At, B1); PG8_BAR;
            PG8_LDB(B0, 1, 0); PG8_SCHED; PG8_LDA(At, 1, 0); PG8_STAGEA(PG8_SA(0, 1), a2 + hstep, voffA);
            PG8_WAIT_L(8); PG8_BAR; PG8_WAIT_L(0); PG8_MMA(0, 0, At, B0); PG8_BAR; PG8_SCHED;
            PG8_LDB(B1, 1, 1); PG8_STAGE(PG8_SB(1, 0), b3, voffB);
            PG8_BAR; PG8_WAIT_L(0); PG8_MMA(0, 1, At, B1); PG8_BAR;
            PG8_LDA(At, 1, 1); PG8_STAGEA(PG8_SA(1, 0), a3, voffA);
            PG8_BAR; PG8_WAIT_L(0); PG8_MMA(1, 0, At, B0); PG8_BAR; PG8_SCHED;
            PG8_STAGE(PG8_SB(1, 1), b3 + hstep, voffB);
            PG8_WAIT_V(6); PG8_BAR; PG8_MMA(1, 1, At, B1); PG8_BAR;
            }
        }
        if constexpr (ALIGN_EPI) { if (wr == 0) PG8_BAR; }
        if constexpr (!Epi::AFTER_DRAIN) { E(acc, cur, wr, wc, fr, fq); S.done(cur, has_next); }
        if (!has_next) break;
#pragma unroll
        for (int a = 0; a < 2; ++a)
#pragma unroll
            for (int b = 0; b < 2; ++b)
#pragma unroll
                for (int m = 0; m < 4; ++m)
#pragma unroll
                    for (int n = 0; n < 2; ++n) acc[a][b][m][n] = (f32x4){0.f, 0.f, 0.f, 0.f};
        cur = nxt; cA = nA; cB = nB; ++ui;
        if constexpr (ALIGN_EPI) { if (wr == 1) PG8_BAR; }
    }
    PG8_WAIT_V(0);
    if constexpr (!ALIGN_EPI) { if (wr == 0) PG8_BAR; }
    PG8_BAR;
    if constexpr (Epi::AFTER_DRAIN) { E.fused(acc, cur, wr, wc, fr, fq, lds, wid, lane); S.done(cur, false); }
#undef PG8_SA
#undef PG8_SB
#undef PG8_STAGE
#undef PG8_STAGEA
#undef PG8_LDA
#undef PG8_LDB
#undef PG8_MMA
#undef PG8_WAIT_V
#undef PG8_WAIT_L
#undef PG8_BAR
#undef PG8_SCHED
}
}

#define LAS __attribute__((address_space(3)))
typedef unsigned short bf16;
typedef short bf16x8 __attribute__((ext_vector_type(8)));
typedef short s16x4 __attribute__((ext_vector_type(4)));
typedef float f32x4 __attribute__((ext_vector_type(4)));
typedef float f32x16 __attribute__((ext_vector_type(16)));
typedef unsigned u32x4 __attribute__((ext_vector_type(4)));
typedef unsigned u32x2 __attribute__((ext_vector_type(2)));
constexpr int TT = pg8::TT, NP = pg8::NP, D = 1024, FF = 2816;
constexpr float LOG2E = pg8::LOG2E;
constexpr size_t MiB = 1u << 20;
constexpr size_t WS_SS = 0, WS_WGU = 1 * MiB, WS_WD = 45 * MiB, WS_WQK = 67 * MiB, WS_WV = 71 * MiB, WS_WO = 73 * MiB, WS_WPW1 = 75 * MiB, WS_WPW2 = 79 * MiB;
constexpr size_t WS_KC = 81 * MiB, WS_VCT = 89 * MiB, WS_XB = 97 * MiB, WS_H = 162 * MiB, WS_Q = WS_H, WS_K = WS_H + 65 * MiB, WS_VT = WS_H + 130 * MiB, WS_O = 357 * MiB, WS_WDWT = 422 * MiB, WS_U = 423 * MiB, WS_END = 488 * MiB;
constexpr size_t WS_CNT = 800 * 1024;
constexpr int CNT_BANK = 130 * 16;
constexpr int LDS_BYTES = 147456, STAT_OFF = 131072;
#define LDS_WAIT() asm volatile("s_waitcnt lgkmcnt(0)" ::: "memory")
__device__ __forceinline__ unsigned pk2(float lo, float hi) { return pg8::cvt_pk_bf16(lo, hi); }
__device__ __forceinline__ float wave_sum(float v) {
#pragma unroll
    for (int o = 1; o < 64; o <<= 1) v += __shfl_xor(v, o);
    return v;
}
struct Args { const float* in[28]; float* out; unsigned char* ws; int ph_lo, ph_hi; };
typedef const __attribute__((address_space(4))) Args CArgs;

#define RLX_AGENT __ATOMIC_RELAXED, __HIP_MEMORY_SCOPE_AGENT
constexpr size_t WS_BAR = 900 * 1024;
constexpr int MISC_OFF = LDS_BYTES - 64;
#define XB_TMO      128
#define XB_XCNT(j)  (256  + 64 * (j))
#define XB_XSUB(j)  (1280 + 64 * (j))
#define XB_XGEN(j)  (2304 + 64 * (j))
#define XB_TOP      3328
#define XB_TOPGEN   3392
#define XCD_BAR_WORDS 3456
#define XB_SPIN_CAP (1u << 18)

__device__ __forceinline__ unsigned xb_ld(unsigned* p)              { return __hip_atomic_load(p, __ATOMIC_RELAXED, __HIP_MEMORY_SCOPE_AGENT); }
__device__ __forceinline__ unsigned xb_add(unsigned* p, unsigned v) { return __hip_atomic_fetch_add(p, v, __ATOMIC_RELAXED, __HIP_MEMORY_SCOPE_AGENT); }
__device__ __forceinline__ unsigned xb_xcc_id() { return (unsigned)__builtin_amdgcn_s_getreg((3 << 11) | 20) & 0xFu; }
#define XB_SPIN(cond, bar) do { unsigned _sp = 0; while (cond) { __builtin_amdgcn_s_sleep(1); \
    if ((++_sp & 255u) == 0u) { if (xb_ld(&(bar)[XB_TMO])) break; if (_sp > XB_SPIN_CAP) { atomicAdd(&(bar)[XB_TMO], 1u); break; } } } } while (0)

struct XcdBarrier {
    unsigned* bar; unsigned x;
    volatile LAS unsigned* st;
};

__device__ __forceinline__ XcdBarrier xcd_barrier_post(unsigned* bar, volatile LAS unsigned* st) {
    XcdBarrier b; b.bar = bar; b.x = xb_xcc_id(); b.st = st;
    if (threadIdx.x == 0) (void)xb_add(&bar[XB_XCNT(b.x)], 1u);
    return b;
}
__device__ __forceinline__ void xcd_barrier_complete(unsigned* bar, unsigned x, unsigned& nloc, unsigned& nx) {
    const unsigned G = gridDim.x * gridDim.y * gridDim.z;
    unsigned sum, cnt, mine, sp = 0u;
    for (;;) {
        sum = 0u; cnt = 0u; mine = 0u;
#pragma unroll
        for (unsigned j = 0; j < 16; ++j) { const unsigned c = xb_ld(&bar[XB_XCNT(j)]); sum += c; cnt += (c > 0u) ? 1u : 0u; mine = (j == x) ? c : mine; }
        if (sum == G) break;
        __builtin_amdgcn_s_sleep(1);
        if ((++sp & 255u) == 0u) { if (xb_ld(&bar[XB_TMO])) break; if (sp > XB_SPIN_CAP) { atomicAdd(&bar[XB_TMO], 1u); break; } }
    }
    nloc = mine > 0u ? mine : 1u; nx = cnt > 0u ? cnt : 1u;
}

__device__ __forceinline__ void xcd_barrier(const XcdBarrier& b) {
    asm volatile("s_waitcnt vmcnt(0)" ::: "memory");
    __syncthreads();
    if (threadIdx.x == 0) {
        unsigned* bar = b.bar;
        __builtin_amdgcn_s_waitcnt(0);
        unsigned nloc = b.st[0], nx = b.st[1];
        if (nloc == 0u) { xcd_barrier_complete(bar, b.x, nloc, nx); b.st[0] = nloc; b.st[1] = nx; }
        const unsigned old = xb_add(&bar[XB_XSUB(b.x)], 1u);
        const unsigned gen = old / nloc;
        if (old + 1u == (gen + 1u) * nloc) {
            __builtin_amdgcn_fence(__ATOMIC_RELEASE, "agent");
            asm volatile("s_waitcnt vmcnt(0)" ::: "memory");
            const unsigned og = xb_add(&bar[XB_TOP], 1u);
            const unsigned tg = og / nx;
            if (og + 1u == (tg + 1u) * nx) xb_add(&bar[XB_TOPGEN], 1u);
            else XB_SPIN(xb_ld(&bar[XB_TOPGEN]) == tg, bar);
            __builtin_amdgcn_fence(__ATOMIC_ACQUIRE, "agent");
            xb_add(&bar[XB_XGEN(b.x)], 1u);
            asm volatile("s_waitcnt vmcnt(0)" ::: "memory");
        } else {
            XB_SPIN(xb_ld(&bar[XB_XGEN(b.x)]) == gen, bar);
            __builtin_amdgcn_fence(__ATOMIC_ACQUIRE, "agent");
            asm volatile("s_waitcnt vmcnt(0)" ::: "memory");
        }
    }
    __syncthreads();
}

struct TItem { const float* W; const float* gain; bf16* dst; int ld, K, k0, n0, drow0; };
__device__ __forceinline__ TItem decode_item(CArgs* ap, unsigned char* ws, int it) {
    int j;
    if (it < 12 * 1408) { j = it / 1408; it -= j * 1408; }
    else { it -= 12 * 1408; if (it < 1024) j = 12; else { it -= 1024; j = 13 + (it >> 9); it &= 511; } }
    TItem I; I.gain = nullptr; int ncols, map;
    if (j < 8) { const int F = j & 3, L = F >> 1, wh = F & 1, up = j >> 2; I.W = ap->in[(wh ? 10 : 6) + up] + (size_t)L * D * FF; I.gain = ap->in[wh ? 9 : 5] + L * D; I.ld = FF; I.K = D; ncols = FF; map = 1 + up; I.dst = (bf16*)(ws + WS_WGU) + (size_t)F * 2 * FF * D; }
    else if (j < 12) { const int F = j - 8, L = F >> 1, wh = F & 1; I.W = ap->in[wh ? 12 : 8] + (size_t)L * FF * D; I.ld = D; I.K = FF; ncols = D; map = 0; I.dst = (bf16*)(ws + WS_WD) + (size_t)F * D * FF; }
    else if (j == 12) { I.W = ap->in[14]; I.ld = 3 * D; I.K = D; ncols = 2 * D; map = 3; I.dst = (bf16*)(ws + WS_WQK); I.gain = ap->in[13]; }
    else if (j == 13) { I.W = ap->in[14] + 2 * D; I.ld = 3 * D; I.K = D; ncols = D; map = 0; I.dst = (bf16*)(ws + WS_WV); I.gain = ap->in[13]; }
    else if (j == 14) { I.W = ap->in[18]; I.ld = D; I.K = D; ncols = D; map = 0; I.dst = (bf16*)(ws + WS_WO); }
    else if (j == 15 || j == 16) { I.W = ap->in[20] + (j - 15) * D; I.ld = 2 * D; I.K = D; ncols = D; map = j - 14; I.dst = (bf16*)(ws + WS_WPW1); I.gain = ap->in[19]; }
    else { I.W = ap->in[26]; I.ld = D; I.K = D; ncols = D; map = 0; I.dst = (bf16*)(ws + WS_WPW2); }
    const int nblk = ncols / 32, kb = it / nblk, nb = it % nblk, n0 = nb * 32;
    if (map == 0) I.drow0 = n0; else if (map == 1) I.drow0 = 256 * (n0 >> 7) + (n0 & 127); else if (map == 2) I.drow0 = 256 * (n0 >> 7) + 128 + (n0 & 127);
    else { const int lb = (n0 & 255) >> 5; I.drow0 = (n0 & ~255) + 32 * (4 * (lb & 1) + (lb >> 1)); }
    I.k0 = kb * 64; I.n0 = n0; return I;
}
__device__ __forceinline__ void item_load(const TItem& I, int lane, f32x4 (&v)[8], float (&g)[8]) {
    const int n4 = lane & 7, kr = lane >> 3; const float* gp = I.gain ? I.gain : I.W;
#pragma unroll
    for (int i = 0; i < 8; ++i) { v[i] = *(const f32x4*)(I.W + (size_t)(I.k0 + 8 * i + kr) * I.ld + I.n0 + 4 * n4); g[i] = gp[I.k0 + 8 * i + kr]; }
}
__device__ __forceinline__ void item_store(const TItem& I, int lane, const f32x4 (&v)[8], const float (&g)[8], LAS float* scr) {
    const int n4 = lane & 7, kr = lane >> 3; const bool hg = I.gain != nullptr;
#pragma unroll
    for (int i = 0; i < 8; ++i) { const int kk = 8 * i + kr; const float gsc = hg ? g[i] : 1.0f;
#pragma unroll
        for (int e = 0; e < 4; ++e) scr[kk * 33 + 4 * n4 + e] = v[i][e] * gsc; }
    LDS_WAIT(); asm volatile("" ::: "memory");
    const int c = lane & 7;
#pragma unroll
    for (int j = 0; j < 4; ++j) { const int n = (lane >> 3) + 8 * j; const LAS float* s = scr + (8 * c) * 33 + n;
        u32x4 o; o.x = pk2(s[0 * 33], s[1 * 33]); o.y = pk2(s[2 * 33], s[3 * 33]); o.z = pk2(s[4 * 33], s[5 * 33]); o.w = pk2(s[6 * 33], s[7 * 33]);
        *(u32x4*)(I.dst + (size_t)(I.drow0 + n) * I.K + I.k0 + 8 * c) = o; }
    LDS_WAIT(); asm volatile("" ::: "memory");
}
__device__ __forceinline__ void p0_prologue(CArgs* ap, LAS unsigned char* lds, int gw, int ngw, int wave, int lane) {
    unsigned char* ws = ap->ws;
    LAS float* scr = (LAS float*)(lds + wave * 8704);
    constexpr int NIT = 12 * 1408 + 1024 + 512 + 512 + 512 + 512 + 512;
    if (gw < NIT) {
        TItem cur = decode_item(ap, ws, gw); f32x4 v[8]; float g[8]; item_load(cur, lane, v, g);
        for (int it0 = gw; it0 < NIT; it0 += ngw) {
            const int nx = (it0 + ngw < NIT) ? it0 + ngw : it0;
            const TItem nxt = decode_item(ap, ws, nx); f32x4 vn[8]; float gn[8]; item_load(nxt, lane, vn, gn);
            item_store(cur, lane, v, g, scr);
            cur = nxt;
#pragma unroll
            for (int i = 0; i < 8; ++i) { v[i] = vn[i]; g[i] = gn[i]; }
        }
    }
    { const float* wd = ap->in[22]; float* wt = (float*)(ws + WS_WDWT); for (int e = gw * 64 + lane; e < 31 * 1024; e += ngw * 64) { const int k = e >> 10, c = e & 1023; wt[(c >> 1) * 64 + 2 * k + (c & 1)] = wd[e]; } }
    { const float* ck = ap->in[2]; const float* cv = ap->in[3]; bf16* kc = (bf16*)(ws + WS_KC); bf16* vc = (bf16*)(ws + WS_VCT); const int nthr = ngw * 64;
      for (int e = gw * 64 + lane; e < 8 * 512 * 16 * 8; e += nthr) { const int c8 = e & 7, h = (e >> 3) & 15, pos = (e >> 7) & 511, s_ = e >> 16;
          const float* src = ck + ((size_t)(s_ * 512 + pos)) * 1024 + h * 64 + c8 * 8; const f32x4 x0 = *(const f32x4*)src, x1 = *(const f32x4*)(src + 4);
          *(u32x4*)(kc + ((size_t)((s_ * 16 + (pos >> 5)) * 16 + h)) * 2048 + (c8 * 32 + (pos & 31)) * 8) = pg8::pack8(x0, x1); }
      for (int e = gw * 64 + lane; e < 8 * 16 * 16 * 8 * 32; e += nthr) { const int d = e & 31, cvi = (e >> 5) & 7, h = (e >> 8) & 15, tbc = (e >> 12) & 15, s_ = e >> 16;
          const int db = cvi >> 2, sl = (cvi >> 1) & 1, kg = cvi & 1; const float* src = cv + ((size_t)(s_ * 512 + 32 * tbc + 16 * sl + 4 * kg)) * 1024 + h * 64 + 32 * db + d; float x[8];
#pragma unroll
          for (int j = 0; j < 8; ++j) x[j] = src[(size_t)((j & 3) + 8 * (j >> 2)) * 1024];
          u32x4 o; o.x = pk2(x[0], x[1]); o.y = pk2(x[2], x[3]); o.z = pk2(x[4], x[5]); o.w = pk2(x[6], x[7]);
          *(u32x4*)(vc + ((size_t)((s_ * 16 + tbc) * 16 + h)) * 2048 + (cvi * 32 + d) * 8) = o; } }
    { bf16* XB = (bf16*)(ws + WS_XB); float* ss0 = (float*)(ws + WS_SS);
      for (int t2 = gw; t2 < TT / 2; t2 += ngw) { f32x4 v[2][4];
#pragma unroll
          for (int r = 0; r < 2; ++r) { const int t = 2 * t2 + r; const float* src = (t < NP) ? ap->in[0] + (size_t)t * D : ap->in[1] + (size_t)(t - NP) * D;
#pragma unroll
              for (int j = 0; j < 4; ++j) v[r][j] = *(const f32x4*)(src + 4 * lane + 256 * j); }
#pragma unroll
          for (int r = 0; r < 2; ++r) { const int t = 2 * t2 + r; float s = 0.f;
#pragma unroll
              for (int j = 0; j < 4; ++j) { const f32x4 x = v[r][j];
                  u32x2 w; w.x = pk2(x[0], x[1]); w.y = pk2(x[2], x[3]); *(u32x2*)(XB + (size_t)t * D + 4 * lane + 256 * j) = w; s += (x[0] * x[0] + x[1] * x[1]) + (x[2] * x[2] + x[3] * x[3]); }
              s = wave_sum(s); if (lane == 0) ss0[t] = s; } } }
}

__device__ __forceinline__ int crow(int r, int hi) { return (r & 3) + 8 * (r >> 2) + 4 * hi; }
__device__ __forceinline__ void attn_phase(LAS unsigned char* lds, const bf16* Q, const bf16* Kb, const bf16* VT, const bf16* Kc, const bf16* VcT, bf16* O, const float* relb, int gw, int ngw, int tid) {
    LAS float* tab = (LAS float*)lds;
    for (int e = tid; e < 16 * 257; e += 512) { const int h = e / 257, idx = e % 257; tab[h * 260 + idx] = (relb[idx * 16 + h] - relb[256 * 16 + h]) * LOG2E; }
    __syncthreads();
    const int lane = tid & 63, q = lane & 31, hi = lane >> 5;
    const bool xmap = (ngw == 2048);
    for (int it = 0, slot = gw; xmap ? (it < 4) : (slot < 8192); ++it, slot += ngw) {
      int unit0, unit1 = 0, nu = 1;
      if (xmap) { const int bxx = gw >> 3, x = bxx & 7, sl = ((bxx >> 3) << 3) + (gw & 7) + 256 * it, hh = 2 * x + (sl & 1), ci = sl >> 1;
          if (ci < 496) { const int b = ci / 248, c = 8 + (ci - b * 248); unit0 = ((b * 256 + c) << 4) | hh; }
          else if (ci < 504) { const int p = ci - 496, b = p >> 2, qq = p & 3; unit0 = ((b * 256 + qq) << 4) | hh; unit1 = ((b * 256 + 7 - qq) << 4) | hh; nu = 2; }
          else unit0 = 8192 + ((ci - 504) << 4) + hh;
      } else
      if (slot < 7936) { const int b = slot / 3968, rem = slot - b * 3968; unit0 = ((b * 256 + 8 + (rem >> 4)) << 4) | (rem & 15); }
      else if (slot < 8064) { const int p = slot - 7936, b = p >> 6, qq = (p >> 4) & 3, hh = p & 15; unit0 = ((b * 256 + qq) << 4) | hh; unit1 = ((b * 256 + 7 - qq) << 4) | hh; nu = 2; }
      else unit0 = 8192 + (slot - 8064);
      for (int ui = 0; ui < nu; ++ui) { const int unit = ui ? unit1 : unit0;
        const int h = unit & 15; int qrow0, tile_lo, sidx = 0; bool samp = false;
        if (unit < 8192) { const int c = (unit >> 4) & 255, b = unit >> 12; qrow0 = b * 16384 + c * 64; tile_lo = c < 8 ? 16 - 2 * c : 0; }
        else { sidx = (unit - 8192) >> 4; qrow0 = NP + 64 * sidx; samp = true; tile_lo = 0; }
        const int bandb = (qrow0 - 512) / 32;
#define ATT_LOAD(t, KF, VF) do { const bool uc = samp && (t) < 16; \
        const size_t blk_ = uc ? ((size_t)((sidx * 16 + (t)) * 16 + h)) * 2048 : ((size_t)((bandb + (t)) * 16 + h)) * 2048; \
        const bf16* kp_ = (uc ? Kc : Kb) + blk_ + (hi * 32 + q) * 8; const bf16* vp_ = (uc ? VcT : VT) + blk_ + (hi * 32 + q) * 8; \
        _Pragma("unroll") for (int d0 = 0; d0 < 4; ++d0) KF[d0] = *(const bf16x8*)(kp_ + d0 * 512); \
        _Pragma("unroll") for (int db = 0; db < 2; ++db) _Pragma("unroll") for (int s = 0; s < 2; ++s) VF[db][s] = *(const bf16x8*)(vp_ + (db * 2 + s) * 512); } while (0)
        bf16x8 Qf[2][4];
#pragma unroll
        for (int qb = 0; qb < 2; ++qb)
#pragma unroll
            for (int d0 = 0; d0 < 4; ++d0) Qf[qb][d0] = *(const bf16x8*)(Q + ((size_t)(((qrow0 >> 5) + qb) * 16 + h)) * 2048 + ((2 * d0 + hi) * 32 + q) * 8);
        f32x16 o[2][2];
#pragma unroll
        for (int qb = 0; qb < 2; ++qb)
#pragma unroll
            for (int db = 0; db < 2; ++db)
#pragma unroll
                for (int r = 0; r < 16; ++r) o[qb][db][r] = 0.f;
        float mrun[2] = {-1e30f, -1e30f}, lrun[2] = {0.f, 0.f};
        bf16x8 Kf[4], Vf[2][2];
        ATT_LOAD(tile_lo, Kf, Vf);
        for (int t = tile_lo; t < 18; ++t) {
            bf16x8 Kn[4], Vn[2][2];
            const int tn = (t + 1 < 18) ? t + 1 : t;
            ATT_LOAD(tn, Kn, Vn);
#pragma unroll
            for (int qb = 0; qb < 2; ++qb) {
                f32x16 sc;
#pragma unroll
                for (int r = 0; r < 16; ++r) sc[r] = 0.f;
#pragma unroll
                for (int d0 = 0; d0 < 4; ++d0) sc = __builtin_amdgcn_mfma_f32_32x32x16_bf16(Kf[d0], Qf[qb][d0], sc, 0, 0, 0);
                if (t >= 12) {
#pragma unroll
                    for (int r = 0; r < 16; ++r) { const int dist = 512 + 32 * qb + q - (32 * t + crow(r, hi)); const int idx = (dist > 128 ? 128 : dist) + 128; sc[r] += tab[h * 260 + idx]; }
                }
                float mx = sc[0];
#pragma unroll
                for (int r = 1; r < 16; ++r) mx = fmaxf(mx, sc[r]);
                mx = fmaxf(mx, __shfl_xor(mx, 32));
                if (__any(mx > mrun[qb] + 8.0f)) {
                    const float mnew = fmaxf(mrun[qb], mx), alpha = __builtin_amdgcn_exp2f(mrun[qb] - mnew); mrun[qb] = mnew; lrun[qb] *= alpha;
#pragma unroll
                    for (int db = 0; db < 2; ++db)
#pragma unroll
                        for (int r = 0; r < 16; ++r) o[qb][db][r] *= alpha; }
                const float mref = mrun[qb]; float ps = 0.f;
#pragma unroll
                for (int r = 0; r < 16; ++r) { sc[r] = __builtin_amdgcn_exp2f(sc[r] - mref); ps += sc[r]; }
                lrun[qb] += ps;
                bf16x8 Pf[2];
#pragma unroll
                for (int s = 0; s < 2; ++s) { u32x4 w; w.x = pk2(sc[8 * s], sc[8 * s + 1]); w.y = pk2(sc[8 * s + 2], sc[8 * s + 3]); w.z = pk2(sc[8 * s + 4], sc[8 * s + 5]); w.w = pk2(sc[8 * s + 6], sc[8 * s + 7]); Pf[s] = __builtin_bit_cast(bf16x8, w); }
#pragma unroll
                for (int db = 0; db < 2; ++db)
#pragma unroll
                    for (int s = 0; s < 2; ++s) o[qb][db] = __builtin_amdgcn_mfma_f32_32x32x16_bf16(Vf[db][s], Pf[s], o[qb][db], 0, 0, 0);
            }
#pragma unroll
            for (int d0 = 0; d0 < 4; ++d0) Kf[d0] = Kn[d0];
#pragma unroll
            for (int db = 0; db < 2; ++db)
#pragma unroll
                for (int s = 0; s < 2; ++s) Vf[db][s] = Vn[db][s];
        }
#undef ATT_LOAD
#pragma unroll
        for (int qb = 0; qb < 2; ++qb) { const float lt = lrun[qb] + __shfl_xor(lrun[qb], 32), inv = 1.0f / lt;
            bf16* orow = O + (size_t)(qrow0 + 32 * qb + q) * 1024 + h * 64;
#pragma unroll
            for (int db = 0; db < 2; ++db)
#pragma unroll
                for (int g = 0; g < 4; ++g) { u32x2 w; w.x = pk2(o[qb][db][4 * g] * inv, o[qb][db][4 * g + 1] * inv); w.y = pk2(o[qb][db][4 * g + 2] * inv, o[qb][db][4 * g + 3] * inv);
                    *(u32x2*)(orow + 32 * db + 8 * g + 4 * hi) = w; } }
      }
    }
}

template <int CTRL> __device__ __forceinline__ float dpp_mov(float v) { return __int_as_float(__builtin_amdgcn_update_dpp(0, __float_as_int(v), CTRL, 0xf, 0xf, false)); }
__device__ __forceinline__ float row16_sum(float v) { v += dpp_mov<0xB1>(v); v += dpp_mov<0x4E>(v); v += dpp_mov<0x124>(v); v += dpp_mov<0x128>(v); return v; }
__device__ __forceinline__ void conv_phase(LAS unsigned char* lds, const bf16* U, const float* state, const float* wdw, const float* bdw, const float* lng, const float* lnb, bf16* Z, int blk, int nblk, int tid) {
    LAS unsigned* tile = (LAS unsigned*)lds;
    typedef float f32x2 __attribute__((ext_vector_type(2)));
    LAS f32x2* stat = (LAS f32x2*)(lds + STAT_OFF);
    LAS f32x2* wpart = (LAS f32x2*)(lds + STAT_OFF + 256);
    const int c0 = 2 * tid, lane = tid & 63, wave = tid >> 6;
    f32x2 w[31];
#pragma unroll
    for (int k = 0; k < 31; ++k) w[k] = *(const f32x2*)(wdw + tid * 64 + 2 * k);
    const f32x2 bd = *(const f32x2*)(bdw + c0), gg = *(const f32x2*)(lng + c0), bb = *(const f32x2*)(lnb + c0);
    for (int unit0 = blk; unit0 < 1024 + 64; unit0 += nblk) {
        const int unit = (nblk == 256 && unit0 < 1024) ? ((blk & 7) * 128 + (unit0 >> 8) * 32 + (blk >> 3)) : unit0;
        int t0, ng, p0; long base; const float* hist = nullptr;
        if (unit < 1024) { t0 = unit * 32; ng = 4; p0 = t0 & 16383; base = t0 - p0; } else { t0 = NP + (unit - 1024) * 8; ng = 1; const int s = (t0 - NP) >> 6; p0 = (t0 - NP) & 63; base = t0 - p0; hist = state + (size_t)s * 30 * 1024; }
        if (p0 >= 32) {
            const char* ub = (const char*)(U + (size_t)(base + p0 - 32) * 1024); const unsigned voff = (unsigned)(tid >> 7) * 2048u + (unsigned)(tid & 127) * 16u;
#pragma unroll
            for (int hb = 0; hb < 2; ++hb) { u32x4 tv[8];
#pragma unroll
                for (int k = 0; k < 8; ++k) tv[k] = *(const u32x4*)(ub + (size_t)(8 * hb + k) * 8192 + voff);
#pragma unroll
                for (int k = 0; k < 8; ++k) *(LAS u32x4*)(lds + (size_t)(8 * hb + k) * 8192 + voff) = tv[k]; }
        } else {
#pragma unroll
        for (int k = 0; k < 16; ++k) { const int idx = tid + 512 * k, j = idx >> 7, pc = idx & 127, pos = p0 - 32 + j; u32x4 v = (u32x4){0u, 0u, 0u, 0u};
            if (pos >= 0) v = *(const u32x4*)(U + (size_t)(base + pos) * 1024 + pc * 8);
            else if (hist && pos >= -30) { const f32x4 x0 = *(const f32x4*)(hist + (size_t)(30 + pos) * 1024 + pc * 8), x1 = *(const f32x4*)(hist + (size_t)(30 + pos) * 1024 + pc * 8 + 4); v = pg8::pack8(x0, x1); }
            *(LAS u32x4*)(lds + (size_t)j * 2048 + pc * 16) = v; }
        }
        __syncthreads();
#pragma unroll 1
        for (int g = 0; g < ng; ++g) {
            f32x2 y[8];
#pragma unroll
            for (int tt = 0; tt < 8; ++tt) y[tt] = bd;
#pragma unroll
            for (int jj = 0; jj < 38; ++jj) { const unsigned v = tile[(8 * g + 2 + jj) * 512 + tid]; const f32x2 rv = (f32x2){__uint_as_float(v << 16), __uint_as_float(v & 0xffff0000u)};
#pragma unroll
                for (int tt = 0; tt < 8; ++tt) { const int k = jj - tt; if (k >= 0 && k <= 30) y[tt] = rv * w[k] + y[tt]; }
                if ((jj & 3) == 3) __builtin_amdgcn_sched_barrier(0); }
#pragma unroll
            for (int tt = 0; tt < 8; ++tt) { const f32x2 sq = y[tt] * y[tt]; const float s1 = row16_sum(y[tt][0] + y[tt][1]), s2 = row16_sum(sq[0] + sq[1]);
                if ((lane & 15) == 0) wpart[(8 * g + tt) * 32 + wave * 4 + (lane >> 4)] = (f32x2){s1, s2};
                tile[(8 * g + tt) * 512 + tid] = pk2(y[tt][0], y[tt][1]); }
        }
        __syncthreads();
        { const int t = tid >> 4, sub = tid & 15; const f32x2 pa = wpart[t * 32 + sub], pb = wpart[t * 32 + sub + 16];
          const float s1 = row16_sum(pa[0] + pb[0]), s2 = row16_sum(pa[1] + pb[1]);
          if (sub == 0) { const float mean = s1 * (1.0f / 1024.0f), var = fmaxf(s2 * (1.0f / 1024.0f) - mean * mean, 0.f); stat[t] = (f32x2){mean, __builtin_amdgcn_rsqf(var + 1e-6f)}; } }
        __syncthreads();
#pragma unroll 8
        for (int t = 0; t < 8 * ng; ++t) { const f32x2 st = stat[t]; const unsigned v = tile[t * 512 + tid]; const float y0 = __uint_as_float(v << 16), y1 = __uint_as_float(v & 0xffff0000u);
            const float a0 = (y0 - st[0]) * st[1] * gg[0] + bb[0], a1 = (y1 - st[0]) * st[1] * gg[1] + bb[1];
            *(unsigned*)(Z + (size_t)(t0 + t) * 1024 + c0) = pk2(a0 * pg8::sigm(a0), a1 * pg8::sigm(a1)); }
        __syncthreads();
    }
}

__global__ void __launch_bounds__(512, 2) mk_fwd(Args args) {
    extern __shared__ __attribute__((aligned(16))) unsigned char lds_raw[];
    LAS unsigned char* lds = (LAS unsigned char*)lds_raw;
    cg::grid_group grid = cg::this_grid();
    const int G = gridDim.x, bx = blockIdx.x;
    const int ngw = G * 8;
    CArgs* kp0 = (CArgs*)__builtin_amdgcn_kernarg_segment_ptr();
    const int ph_lo = kp0->ph_lo, ph_hi = kp0->ph_hi;
    if (threadIdx.x < 16) ((volatile LAS unsigned*)(lds + MISC_OFF))[threadIdx.x] = 0u;
    __syncthreads();
    const XcdBarrier bar = xcd_barrier_post((unsigned*)(kp0->ws + WS_BAR), (volatile LAS unsigned*)(lds + MISC_OFF));
    const int tid0 = threadIdx.x;
#ifdef REP_MASK
    int rep = 0;
#endif
    unsigned* pend = nullptr;
    for (int ph = ph_lo; ph < ph_hi; ++ph) {
        CArgs* kp = kp0; asm volatile("" : "+s"(kp));
        unsigned char* ws = kp->ws; float* X = kp->out; float* ssb = (float*)(ws + WS_SS); unsigned* cntb = (unsigned*)(ws + WS_CNT);
        bf16* XB = (bf16*)(ws + WS_XB); bf16* H = (bf16*)(ws + WS_H); bf16* OB = (bf16*)(ws + WS_O);
        int tid = tid0; asm volatile("" : "+v"(tid));
        const int lane = tid & 63, wave = __builtin_amdgcn_readfirstlane(tid >> 6); const int gw = bx * 8 + wave;
        int depb = -1, mineb = -1, start = 0; unsigned need = 0;
        switch (ph) {
        case 1: mineb = 0; start = 0; break;            case 2: depb = 0; need = 176; start = 26; break;
        case 5: mineb = 1; start = 0; break;            case 6: depb = 1; need = 32; mineb = 2; start = 31; break;
        case 7: depb = 2; need = 176; mineb = 3; start = 25; break;   case 8: depb = 3; need = 32; mineb = 4; start = 24; break;
        case 9: depb = 4; need = 176; mineb = 5; start = 18; break;   case 10: depb = 5; need = 32; start = 17; break;
        case 12: mineb = 6; start = 0; break;           case 13: depb = 6; need = 32; mineb = 7; start = 31; break;
        case 14: depb = 7; need = 176; start = 25; break;
        default: break; }
#ifdef NOCHAIN
        depb = -1; mineb = -1; start = 0;
#endif
        pg8::ChainOrder S; S.dep = depb >= 0 ? cntb + depb * CNT_BANK : nullptr; S.need = need; S.mine = mineb >= 0 ? cntb + mineb * CNT_BANK : nullptr; S.pendp = &pend; S.lane = lane; S.okflag = (volatile LAS unsigned*)(lds + MISC_OFF + 16); S.rot = start; S.rl = (ph == 1) ? 6 : (ph == 6 || ph == 13) ? 7 : (ph == 8) ? 14 : -1; S.h0 = (ph == 8) ? 22 : 20;
        const int crot = bx;
        switch (ph) {
#ifndef PHMASK
#define PHMASK 0xFFFF
#endif
#define PHON(k) ((PHMASK >> (k)) & 1)
        case 0: if (PHON(0)) p0_prologue(kp, lds, gw, ngw, wave, lane); break;
        case 1: case 6: case 8: case 13: if (PHON(1)) {
            const int F = (ph == 1) ? 0 : (ph == 6) ? 1 : (ph == 8) ? 2 : 3, si = (ph == 1) ? 0 : (ph == 6) ? 2 : (ph == 8) ? 3 : 5;
            pg8::Gemm g{XB, (const bf16*)(ws + WS_WGU) + (size_t)F * 2 * FF * D, TT, 2 * FF, D}; S.init(TT, 2 * FF, G, crot);
            pg8::EpiGlu<0> E{H, FF, ssb + (size_t)si * TT, nullptr, 0, nullptr, nullptr, &pend, lane};
            pg8::gemm_phase<pg8::EpiGlu<0>, pg8::ChainOrder, true, true, false>(lds, g, S, E, tid); } break;
        case 2: case 7: case 9: case 14: case 5: case 12: if (PHON(2)) {
            const bf16* A; const bf16* B; int K; float alpha; const float* bias = nullptr; int so;
            if (ph == 5) { A = OB; B = (const bf16*)(ws + WS_WO); K = D; alpha = 1.0f; so = 2; }
            else if (ph == 12) { A = OB; B = (const bf16*)(ws + WS_WPW2); K = D; alpha = 1.0f; bias = kp->in[27]; so = 5; }
            else { const int F = (ph == 2) ? 0 : (ph == 7) ? 1 : (ph == 9) ? 2 : 3; A = H; B = (const bf16*)(ws + WS_WD) + (size_t)F * D * FF; K = FF; alpha = 0.5f; so = (ph == 2) ? 1 : (ph == 7) ? 3 : (ph == 9) ? 4 : -1; }
            pg8::Gemm g{A, B, TT, D, K}; S.init(TT, D, G, crot);
            pg8::EpiRes E{X, so >= 0 ? XB : nullptr, so >= 0 ? ssb + (size_t)so * TT : nullptr, bias, alpha, &pend, lane, (ph == 2) ? kp->in[0] : nullptr, (ph == 2) ? kp->in[1] : nullptr};
            pg8::gemm_phase<pg8::EpiRes, pg8::ChainOrder, true, true, false>(lds, g, S, E, tid); } break;
        case 3: if (PHON(3)) {
            { pg8::Gemm g{XB, (const bf16*)(ws + WS_WQK), TT, 2 * D, D}; pg8::StaticOrder S0; S0.init(TT, 2 * D, G, bx);
              pg8::EpiQK E{(bf16*)(ws + WS_Q), (bf16*)(ws + WS_K), ssb + (size_t)1 * TT, kp->in[15], kp->in[16], X + 34078720, X + 36175872};
              pg8::gemm_phase<pg8::EpiQK, pg8::StaticOrder, true, true>(lds, g, S0, E, tid); }
            { pg8::Gemm g{(const bf16*)(ws + WS_WV), XB, D, TT, D}; pg8::StaticOrder S0; S0.init(D, TT, G, (G == 256) ? ((bx + 128) & 255) : bx);
              pg8::EpiVT E{(bf16*)(ws + WS_VT), ssb + (size_t)1 * TT, X + 35127296, X + 36700160};
              pg8::gemm_phase<pg8::EpiVT, pg8::StaticOrder, true, true>(lds, g, S0, E, tid); } } break;
        case 4: if (PHON(4)) attn_phase(lds, (const bf16*)(ws + WS_Q), (const bf16*)(ws + WS_K), (const bf16*)(ws + WS_VT), (const bf16*)(ws + WS_KC), (const bf16*)(ws + WS_VCT), OB, kp->in[17], gw, ngw, tid); break;
        case 10: if (PHON(10)) {
            pg8::Gemm g{XB, (const bf16*)(ws + WS_WPW1), TT, 2 * D, D}; S.init(TT, 2 * D, G, crot);
            pg8::EpiGlu<1> E{(bf16*)(ws + WS_U), D, ssb + (size_t)4 * TT, kp->in[21], D, X + 37224448, X + 37285888, &pend, lane};
            pg8::gemm_phase<pg8::EpiGlu<1>, pg8::ChainOrder, true, true, false>(lds, g, S, E, tid); } break;
        case 11: if (PHON(11)) conv_phase(lds, (const bf16*)(ws + WS_U), kp->in[4], (const float*)(ws + WS_WDWT), kp->in[23], kp->in[24], kp->in[25], OB, bx, G, tid); break;
        default: break;
        }
#ifdef NOCHAIN
        const bool chain_inner = false;
#else
        const bool chain_inner = (ph == 1) || (ph >= 5 && ph <= 9) || ph == 12 || ph == 13;
#endif
        if (!chain_inner || ph + 1 >= ph_hi) { if (pend) { asm volatile("s_waitcnt vmcnt(0)" ::: "memory"); if (lane == 0) __hip_atomic_fetch_add(pend, 1u, __ATOMIC_RELAXED, __HIP_MEMORY_SCOPE_AGENT); pend = nullptr; } }
        if (ph + 1 < ph_hi && !chain_inner) { if (ph_hi > 1000) grid.sync();   xcd_barrier(bar); }
    }
}

#ifndef MK_N_LAUNCHES
#define MK_N_LAUNCHES 1
#endif
extern "C" void kernel_launch(void* const* d_in, const int* in_sizes, int n_in, void* d_out, int out_size, void* d_ws, size_t ws_size, hipStream_t stream) {
    static int grid = 0;
    if (grid == 0) {
        if (n_in != 28 || out_size != 37531648 || ws_size < WS_END) { fprintf(stderr, "kernel_launch: unexpected problem: n_in %d out %d ws %zu\n", n_in, out_size, ws_size); grid = -1; return; }
        int dev = 0, cus = 0, per_cu = 0;
        (void)hipGetDevice(&dev); (void)hipDeviceGetAttribute(&cus, hipDeviceAttributeMultiprocessorCount, dev);
        if (hipFuncSetAttribute((const void*)mk_fwd, hipFuncAttributeMaxDynamicSharedMemorySize, LDS_BYTES) != hipSuccess) { fprintf(stderr, "kernel_launch: hipFuncSetAttribute failed\n"); grid = -1; return; }
        if (hipOccupancyMaxActiveBlocksPerMultiprocessor(&per_cu, (const void*)mk_fwd, 512, LDS_BYTES) != hipSuccess || per_cu < 1) { fprintf(stderr, "kernel_launch: occupancy query gave %d\n", per_cu); per_cu = 1; }
        (void)hipGetLastError();
        grid = cus * per_cu; if (grid <= 0) grid = 256;
    }
    if (grid < 0) return;
    (void)hipMemsetAsync((char*)d_ws + WS_SS, 0, 1 * MiB, stream);
    Args a{};
    for (int i = 0; i < 28; ++i) a.in[i] = (const float*)d_in[i];
    a.out = (float*)d_out; a.ws = (unsigned char*)d_ws;
    constexpr int NPH = 15;
    if (MK_N_LAUNCHES == 1) {
        a.ph_lo = 0; a.ph_hi = NPH; void* kargs[] = {&a};
        hipError_t e = hipLaunchCooperativeKernel((const void*)mk_fwd, dim3(grid), dim3(512), kargs, LDS_BYTES, stream);
        if (e != hipSuccess) fprintf(stderr, "kernel_launch: cooperative launch failed: %s (grid %d)\n", hipGetErrorString(e), grid);
    } else {
        for (int p = 0; p < NPH; ++p) { a.ph_lo = p; a.ph_hi = p + 1; hipLaunchKernelGGL(mk_fwd, dim3(grid), dim3(512), LDS_BYTES, stream, a); }
    }
}
```
